# Optimizing an MI355X kernel written in HIP

```python
import math
import jax, jax.numpy as jnp
from jax import lax
import numpy as np

D_MODEL = 1024
BATCH = 8
SEQ = 2048
DEPTH = 1

HEAD_DIM = 64
MIX_WIDTH = D_MODEL
DIFF_WIDTH = MIX_WIDTH // 2
SB_WIDTH = MIX_WIDTH - DIFF_WIDTH
N_DIFF_HEADS = DIFF_WIDTH // (2 * HEAD_DIM)
DIFF_V_DIM = 2 * HEAD_DIM
N_SB_HEADS = SB_WIDTH // HEAD_DIM
QBLOCK = 128
NUM_BUCKETS = 32
MAX_DISTANCE = 128
N_EXPERTS = 32
TOP_K = 4
D_EXPERT = D_MODEL
SWIGLU_LIMIT = 7.0
SWIGLU_ALPHA = 1.702
PLE_DIM = 256
NORM_EPS = 1e-6
SPLIT_SIZES = (N_DIFF_HEADS * HEAD_DIM, N_DIFF_HEADS * HEAD_DIM, N_DIFF_HEADS * HEAD_DIM,
               N_DIFF_HEADS * HEAD_DIM, N_DIFF_HEADS * DIFF_V_DIM,
               N_SB_HEADS * HEAD_DIM, N_SB_HEADS * HEAD_DIM, N_SB_HEADS * HEAD_DIM)
IN_WIDTH = sum(SPLIT_SIZES)

kernel_name = "hybrid_diffattn_stickbreak_moe_ple"


def rms_norm(x, g):
    x32 = x.astype(jnp.float32)
    y = x32 * lax.rsqrt(jnp.mean(x32 * x32, axis=-1, keepdims=True) + NORM_EPS)
    return (y * g.astype(jnp.float32)).astype(x.dtype)


def t5_bucket(rel):
    n = jnp.maximum(rel, 0)
    max_exact = NUM_BUCKETS // 2
    nf = jnp.maximum(n, 1).astype(jnp.float32)
    large = max_exact + (jnp.log(nf / max_exact) / math.log(MAX_DISTANCE / max_exact)
                         * (NUM_BUCKETS - max_exact)).astype(jnp.int32)
    large = jnp.minimum(large, NUM_BUCKETS - 1)
    return jnp.where(n < max_exact, n, large)


def to_query_blocks(t):
    b, s, h, d = t.shape
    return t.reshape(b, s // QBLOCK, QBLOCK, h, d).transpose(1, 0, 3, 2, 4)


def from_query_blocks(t):
    nb, b, h, blk, d = t.shape
    return t.transpose(1, 0, 3, 2, 4).reshape(b, nb * blk, h * d)


def diff_attention(q1, q2, k1, k2, v, lam, subln_g, lambda_init, rel_bias):
    seq = q1.shape[1]
    scale = HEAD_DIM ** -0.5
    k1h, k2h, vh = [t.transpose(0, 2, 1, 3) for t in (k1, k2, v)]
    kpos = jnp.arange(seq)
    bias_table = rel_bias.astype(jnp.float32)

    def block(args):
        q1b, q2b, qpos = args
        rel = qpos[:, None] - kpos[None, :]
        causal = rel >= 0
        bias = bias_table[t5_bucket(rel)].transpose(2, 0, 1)

        def softmax_map(qb, kh):
            s = jnp.einsum('bhqd,bhkd->bhqk', qb, kh).astype(jnp.float32) * scale + bias
            s = jnp.where(causal, s, -jnp.inf)
            return jax.nn.softmax(s, axis=-1)

        a = softmax_map(q1b, k1h) - lam * softmax_map(q2b, k2h)
        o = jnp.einsum('bhqk,bhkd->bhqd', a.astype(vh.dtype), vh)
        return rms_norm(o, subln_g) * (1.0 - lambda_init)

    nb = seq // QBLOCK
    qpos = jnp.arange(seq).reshape(nb, QBLOCK)
    out = lax.map(block, (to_query_blocks(q1), to_query_blocks(q2), qpos))
    return from_query_blocks(out)


def stick_breaking_attention(q, k, v):
    seq = q.shape[1]
    scale = HEAD_DIM ** -0.5
    kh, vh = [t.transpose(0, 2, 1, 3) for t in (k, v)]
    kpos = jnp.arange(seq)

    def block(args):
        qb, qpos = args
        z = jnp.einsum('bhqd,bhkd->bhqk', qb, kh).astype(jnp.float32) * scale
        strict = kpos[None, :] < qpos[:, None]
        log_keep = jnp.where(strict, jax.nn.log_sigmoid(-z), 0.0)
        later = lax.cumsum(log_keep, axis=3, reverse=True) - log_keep
        w = jnp.where(strict, jnp.exp(jax.nn.log_sigmoid(z) + later), 0.0)
        return jnp.einsum('bhqk,bhkd->bhqd', w.astype(vh.dtype), vh)

    nb = seq // QBLOCK
    qpos = jnp.arange(seq).reshape(nb, QBLOCK)
    out = lax.map(block, (to_query_blocks(q), qpos))
    return from_query_blocks(out)


def moe_ffn(xn, router_w, router_b, w_gate_up, b_gate_up, w_down, b_down):
    b, s, d = xn.shape
    t = xn.reshape(b * s, d)
    logits = (t @ router_w + router_b).astype(jnp.float32)
    top_v, top_i = lax.top_k(logits, TOP_K)
    gates = jax.nn.softmax(top_v, axis=-1)
    combine = jnp.einsum('nk,nke->ne', gates, jax.nn.one_hot(top_i, N_EXPERTS, dtype=jnp.float32))
    y = jnp.zeros((b * s, d), jnp.float32)
    for e in range(N_EXPERTS):
        gu = t @ w_gate_up[e] + b_gate_up[e]
        glu = jnp.minimum(gu[:, ::2], SWIGLU_LIMIT)
        lin = jnp.clip(gu[:, 1::2], -SWIGLU_LIMIT, SWIGLU_LIMIT)
        act = glu * jax.nn.sigmoid(SWIGLU_ALPHA * glu) * (lin + 1.0)
        y = y + combine[:, e:e + 1] * (act @ w_down[e] + b_down[e])
    return y.astype(xn.dtype).reshape(b, s, d)


def setup_inputs(seed: int = 0) -> dict:
    key = jax.random.key(seed)
    ks = jax.random.split(key, 22)
    f32 = jnp.float32
    nrm = lambda k, shape: jax.random.normal(k, shape, f32)
    return {
        "x": nrm(ks[0], (BATCH, SEQ, D_MODEL)),
        "p": nrm(ks[1], (DEPTH, BATCH, SEQ, PLE_DIM)),
        "w_in": nrm(ks[2], (DEPTH, D_MODEL, IN_WIDTH)) * D_MODEL ** -0.5,
        "w_out": nrm(ks[3], (DEPTH, MIX_WIDTH, D_MODEL)) * MIX_WIDTH ** -0.5,
        "attn_norm": 1.0 + 0.05 * nrm(ks[4], (DEPTH, D_MODEL)),
        "moe_norm": 1.0 + 0.05 * nrm(ks[5], (DEPTH, D_MODEL)),
        "rel_bias": 0.1 * nrm(ks[6], (NUM_BUCKETS, N_DIFF_HEADS)),
        "lambda_q1": 0.1 * nrm(ks[7], (DEPTH, HEAD_DIM)),
        "lambda_k1": 0.1 * nrm(ks[8], (DEPTH, HEAD_DIM)),
        "lambda_q2": 0.1 * nrm(ks[9], (DEPTH, HEAD_DIM)),
        "lambda_k2": 0.1 * nrm(ks[10], (DEPTH, HEAD_DIM)),
        "subln": 1.0 + 0.05 * nrm(ks[11], (DEPTH, DIFF_V_DIM)),
        "router_w": nrm(ks[12], (DEPTH, D_MODEL, N_EXPERTS)) * D_MODEL ** -0.5,
        "router_b": 0.01 * nrm(ks[13], (DEPTH, N_EXPERTS)),
        "w_gate_up": nrm(ks[14], (DEPTH, N_EXPERTS, D_MODEL, 2 * D_EXPERT)) * D_MODEL ** -0.5,
        "b_gate_up": 0.01 * nrm(ks[15], (DEPTH, N_EXPERTS, 2 * D_EXPERT)),
        "w_down": nrm(ks[16], (DEPTH, N_EXPERTS, D_EXPERT, D_MODEL)) * D_EXPERT ** -0.5,
        "b_down": 0.01 * nrm(ks[17], (DEPTH, N_EXPERTS, D_MODEL)),
        "ple_proj": nrm(ks[18], (DEPTH, PLE_DIM, D_MODEL)) * PLE_DIM ** -0.5,
        "ple_norm": 1.0 + 0.05 * nrm(ks[19], (DEPTH, D_MODEL)),
        "ple_gate": nrm(ks[20], (DEPTH, D_MODEL, D_MODEL)) * D_MODEL ** -0.5,
        "final_norm": 1.0 + 0.05 * nrm(ks[21], (D_MODEL,)),
    }


def reference(x, p, w_in, w_out, attn_norm, moe_norm, rel_bias, lambda_q1, lambda_k1,
              lambda_q2, lambda_k2, subln, router_w, router_b, w_gate_up, b_gate_up,
              w_down, b_down, ple_proj, ple_norm, ple_gate, final_norm):
    split_points = np.cumsum(SPLIT_SIZES)[:-1].tolist()
    h = x
    for i in range(DEPTH):
        hn = rms_norm(h, attn_norm[i])
        proj = hn @ w_in[i]
        b, s, _ = proj.shape
        dq1, dq2, dk1, dk2, dv, sq, sk, sv = jnp.split(proj, split_points, axis=-1)
        hd = lambda t, n: t.reshape(b, s, n, -1)
        lambda_init = 0.8 - 0.6 * math.exp(-0.3 * i)
        lam = (jnp.exp(jnp.sum(lambda_q1[i].astype(jnp.float32) * lambda_k1[i].astype(jnp.float32)))
               - jnp.exp(jnp.sum(lambda_q2[i].astype(jnp.float32) * lambda_k2[i].astype(jnp.float32)))
               + lambda_init)
        o_diff = diff_attention(hd(dq1, N_DIFF_HEADS), hd(dq2, N_DIFF_HEADS), hd(dk1, N_DIFF_HEADS),
                                hd(dk2, N_DIFF_HEADS), hd(dv, N_DIFF_HEADS), lam, subln[i],
                                lambda_init, rel_bias)
        o_sb = stick_breaking_attention(hd(sq, N_SB_HEADS), hd(sk, N_SB_HEADS), hd(sv, N_SB_HEADS))
        h = h + jnp.concatenate([o_diff, o_sb], axis=-1) @ w_out[i]
        h = h + moe_ffn(rms_norm(h, moe_norm[i]), router_w[i], router_b[i], w_gate_up[i],
                        b_gate_up[i], w_down[i], b_down[i])
        gate = jax.nn.sigmoid(h @ ple_gate[i])
        h = h + gate * rms_norm(p[i] @ ple_proj[i], ple_norm[i])
    return rms_norm(h, final_norm)
```

```cpp
#include <hip/hip_runtime.h>
#include <cstdio>
#include <cstdint>

#ifndef MK_N_LAUNCHES
#define MK_N_LAUNCHES 1
#endif
#ifndef MK_PIPE
#define MK_PIPE 3
#endif

#define LAS __attribute__((address_space(3)))
#define GAS __attribute__((address_space(1)))
typedef unsigned short bf16;
typedef short bf16x8 __attribute__((ext_vector_type(8)));
typedef short s16x4 __attribute__((ext_vector_type(4)));
typedef short v4i16_t __attribute__((ext_vector_type(4)));
typedef float f32x2 __attribute__((ext_vector_type(2)));
typedef float f32x4 __attribute__((ext_vector_type(4)));
typedef float f32x16 __attribute__((ext_vector_type(16)));
typedef unsigned u32x2 __attribute__((ext_vector_type(2)));
typedef unsigned u32x4 __attribute__((ext_vector_type(4)));
typedef unsigned v4u __attribute__((ext_vector_type(4)));
typedef GAS unsigned gu32;

constexpr int NBATCH = 8, SEQ = 2048, DM = 1024, M = NBATCH * SEQ, NIN = 3072, NEXP = 32, TOPK = 4, PLE = 256;
constexpr int LCAP = 16384;
constexpr int MAXTILES = 288;
constexpr float NORM_EPS = 1e-6f;
constexpr float LOG2E = 1.4426950408889634f;
constexpr float C2 = 0.125f * LOG2E;
constexpr float LAMBDA_INIT = 0.2f;
constexpr int C_Q1 = 0, C_Q2 = 256, C_K1 = 512, C_K2 = 768, C_DV = 1024, C_SQ = 1536, C_SK = 2048, C_SV = 2560;

constexpr size_t MiB = 1u << 20;
constexpr size_t WS_CTL = 0, CTL_ZERO_BYTES = 1 * MiB;
constexpr size_t WS_TINFO = 1 * MiB;
constexpr size_t WS_LIST = 2 * MiB;
constexpr size_t WS_LGATE = 4 * MiB;
constexpr size_t WS_WIN = 6 * MiB;
constexpr size_t WS_WOUT = 12 * MiB;
constexpr size_t WS_WPG = 14 * MiB;
constexpr size_t WS_WPP = 16 * MiB;
constexpr size_t WS_XN = 20 * MiB;
constexpr size_t WS_O = 52 * MiB;
constexpr size_t WS_PROJ = 84 * MiB;
constexpr size_t WS_H1 = 180 * MiB;
constexpr size_t WS_PERAW = 244 * MiB;
constexpr size_t WS_PE16 = 308 * MiB;
constexpr size_t WS_P16 = 340 * MiB;
constexpr size_t WS_WGU = 352 * MiB;
constexpr size_t WS_WDN = 480 * MiB;
constexpr size_t WS_ACT = 544 * MiB;
constexpr size_t WS_Y = 688 * MiB;
constexpr size_t WS_END = 832 * MiB;
constexpr int CW_ATTQ = 64;
constexpr int CW_GCNT = 1024;
constexpr int CW_BAR = 4096;

constexpr int RING_BYTES = 131072;
constexpr int MISC_OFF = RING_BYTES;
constexpr int TAB_OFF = RING_BYTES + 256;
constexpr int LDS_BYTES = 147456;

constexpr int NWAVES = 8;
constexpr int N_PHASES = 10;

#define RLX_AGENT __ATOMIC_RELAXED, __HIP_MEMORY_SCOPE_AGENT
#define LDS_WAIT() asm volatile("s_waitcnt lgkmcnt(0)" ::: "memory")
#define VM_WAIT() asm volatile("s_waitcnt vmcnt(0)" ::: "memory")
__device__ __forceinline__ unsigned f2bf(float f) { unsigned u = __builtin_bit_cast(unsigned, f); return (u + 0x7fffu + ((u >> 16) & 1u)) >> 16; }
__device__ __forceinline__ unsigned pk2(float lo, float hi) { return f2bf(lo) | (f2bf(hi) << 16); }
__device__ __forceinline__ unsigned cvt_pk_bf16(float lo, float hi) { unsigned r; asm volatile("v_cvt_pk_bf16_f32 %0, %1, %2" : "=v"(r) : "v"(lo), "v"(hi)); return r; }
__device__ __forceinline__ float bf_lo(unsigned w) { return __builtin_bit_cast(float, w << 16); }
__device__ __forceinline__ float bf_hi(unsigned w) { return __builtin_bit_cast(float, w & 0xffff0000u); }
__device__ __forceinline__ float wave_sum(float v) {
#pragma unroll
    for (int o = 1; o < 64; o <<= 1) v += __shfl_xor(v, o);
    return v;
}
__device__ __forceinline__ float fast_sigmoid(float a) { return __builtin_amdgcn_rcpf(1.0f + __builtin_amdgcn_exp2f(-a * LOG2E)); }

namespace pg8 {
constexpr int BM = 256, BK = 64, HALF = 128, HTB = HALF * BK * 2, STAGE_BYTES = 8 * HTB, NXCD = 8, WGM = 8;
__host__ __device__ __forceinline__ int lds_byte(int r, int c) { const int st = (r >> 4) * 2 + (c >> 5), rr = r & 15, cc = c & 31, ob = rr * 64 + cc * 2; return st * 1024 + (ob ^ (((ob >> 9) & 1) << 5)); }
__host__ __device__ __forceinline__ void stage_rc(int b, int& R, int& C) { const int st = b / 1024, sb = b % 1024, swz = sb ^ (((sb >> 9) & 1) << 5); R = (st >> 1) * 16 + swz / 64; C = (st & 1) * 32 + (swz % 64) / 2; }
__host__ __device__ __forceinline__ int perm32(int rho) { const int n = rho >> 4, i = rho & 15; return 8 * (i >> 2) + 4 * n + (i & 3); }

struct Unit { int pm, pn, e, T; };

struct DenseOrder {
    const bf16* A; const bf16* Bt; int K, nM, nN, nwg, G, c;
    __device__ __forceinline__ void init(const bf16* A_, const bf16* Bt_, int M_, int N_, int K_, int G_, int c_) { A = A_; Bt = Bt_; K = K_; nM = M_ / BM; nN = N_ / BM; nwg = nM * nN; G = G_; c = c_; }
    __device__ __forceinline__ bool next(int i, Unit& u) const {
        const long L = (long)i * G + c; if (L >= nwg) return false;
        int wgid = (int)L; { const int q = nwg / NXCD, r = nwg % NXCD, xcd = wgid % NXCD, off = wgid / NXCD; wgid = (xcd < r ? xcd * (q + 1) : r * (q + 1) + (xcd - r) * q) + off; }
        const int nig = WGM * nN, gid = wgid / nig, fm = gid * WGM, gsz = (nM - fm) < WGM ? (nM - fm) : WGM;
        u.pm = fm + ((wgid % nig) % gsz); u.pn = (wgid % nig) / gsz; u.e = 0; u.T = u.pm; return true;
    }
    __device__ __forceinline__ const char* a_base() const { return (const char*)A; }
    __device__ __forceinline__ unsigned a_row(const Unit& u, int r) const { return (unsigned)(u.T * BM + r); }
    __device__ __forceinline__ const char* b_ptr(const Unit& u) const { return (const char*)Bt + (size_t)u.pn * BM * K * 2; }
};

template <bool GATHER, int NN  , int TPX  >
struct GroupedOrder {
    const bf16* A; const bf16* Bt; size_t b_estride; const int* list; const LAS int* tp; const LAS int* cnt; int K, G, c;
    __device__ __forceinline__ bool next(int i, Unit& u) const {
        const int tiles = tp[NEXP];
        const int L = i * G + c, round = L >> 8, w = L & 255, x = w & 7, j = w >> 3;
        const int T = round * (8 * TPX) + x * TPX + j / NN; if (T >= tiles) return false;
        int e = 0;
#pragma unroll 1
        for (int k = 16; k >= 1; k >>= 1) { if (tp[e + k] <= T) e += k; }
        u.e = __builtin_amdgcn_readfirstlane(e); u.T = __builtin_amdgcn_readfirstlane(T); u.pm = u.T - __builtin_amdgcn_readfirstlane(tp[u.e]); u.pn = j % NN; return true;
    }
    __device__ __forceinline__ const char* a_base() const { return (const char*)A; }
    __device__ __forceinline__ unsigned a_row(const Unit& u, int r) const {
        if constexpr (GATHER) { const int idx = u.pm * BM + r; return (idx < cnt[u.e]) ? (unsigned)list[u.e * LCAP + idx] : 0u; }
        else return (unsigned)(u.T * BM + r);
    }
    __device__ __forceinline__ const char* b_ptr(const Unit& u) const { return (const char*)Bt + (size_t)u.e * b_estride + (size_t)u.pn * BM * K * 2; }
};

template <class Epi, class Sched, bool ALIGN_EPI>
__device__ __forceinline__ void gemm_phase(LAS unsigned char* lds, const Sched& S, const Epi& E) {
    const int tid = threadIdx.x, wid = __builtin_amdgcn_readfirstlane(tid >> 6), lane = tid & 63, wr = wid >> 2, wc = wid & 3, fr = lane & 15, fq = lane >> 4;
    const int K = S.K, nt = K / BK;
    int RA[2], CA[2]; unsigned voffB[2];
#pragma unroll
    for (int i = 0; i < 2; ++i) { int R, C; stage_rc(tid * 16 + i * 8192, R, C); const int Rb = Epi::PERM ? ((R & ~31) + perm32(R & 31)) : R;
        RA[i] = R; CA[i] = C; voffB[i] = (unsigned)(Rb * K + C) * 2u; }
    const size_t kstep = (size_t)(BK * 2);
    const size_t hstep = (size_t)HALF * K * 2;
    const unsigned ldsw = (unsigned)wid * 1024u;
    const int aoff = lds_byte(wr * 64 + fr, fq * 8), boff = lds_byte(wc * 32 + fr, fq * 8);
#define PG8_SA(b, h) (((b) * 2 + (h)) * HTB)
#define PG8_SB(b, h) ((4 + (b) * 2 + (h)) * HTB)
#define PG8_STAGE(bufoff, gbase, voff) do { _Pragma("unroll") for (int _i = 0; _i < 2; ++_i) \
        __builtin_amdgcn_global_load_lds((const unsigned*)((const char*)(gbase) + (voff)[_i]), (LAS unsigned*)(lds + (bufoff) + ldsw + _i * 8192), 16, 0, 0); } while (0)
#define PG8_LDA(dst, b, h) do { _Pragma("unroll") for (int m = 0; m < 4; ++m) _Pragma("unroll") for (int k = 0; k < 2; ++k) dst[m][k] = *(const LAS bf16x8*)(lds + PG8_SA(b, h) + aoff + m * 2048 + k * 1024); } while (0)
#define PG8_LDB(dst, b, h) do { _Pragma("unroll") for (int n = 0; n < 2; ++n) _Pragma("unroll") for (int k = 0; k < 2; ++k) dst[n][k] = *(const LAS bf16x8*)(lds + PG8_SB(b, h) + boff + n * 2048 + k * 1024); } while (0)
#define PG8_MMA(ai, bj, At, Bt) do { __builtin_amdgcn_s_setprio(1); _Pragma("unroll") for (int m = 0; m < 4; ++m) _Pragma("unroll") for (int n = 0; n < 2; ++n) _Pragma("unroll") for (int k = 0; k < 2; ++k) \
        acc[ai][bj][m][n] = __builtin_amdgcn_mfma_f32_16x16x32_bf16(Bt[n][k], At[m][k], acc[ai][bj][m][n], 0, 0, 0); __builtin_amdgcn_s_setprio(0); } while (0)
#define PG8_WAIT_V(n) asm volatile("s_waitcnt vmcnt(" #n ")" ::: "memory")
#define PG8_WAIT_L(n) asm volatile("s_waitcnt lgkmcnt(" #n ")" ::: "memory")
#define PG8_BAR __builtin_amdgcn_s_barrier()
#define PG8_SCHED __builtin_amdgcn_sched_barrier(0)
    Unit cur, nxt, nx2; int ui = 0;
    if (!S.next(0, cur)) return;
    bool has_next = S.next(1, nxt);
    unsigned vcur[2][2], vnxt[2][2];
#pragma unroll
    for (int h = 0; h < 2; ++h)
#pragma unroll
        for (int i = 0; i < 2; ++i) vcur[h][i] = (S.a_row(cur, h * HALF + RA[i]) * (unsigned)K + (unsigned)CA[i]) * 2u;
#pragma unroll
    for (int h = 0; h < 2; ++h)
#pragma unroll
        for (int i = 0; i < 2; ++i) vnxt[h][i] = has_next ? (S.a_row(nxt, h * HALF + RA[i]) * (unsigned)K + (unsigned)CA[i]) * 2u : vcur[h][i];
    f32x4 acc[2][2][4][2];
#pragma unroll
    for (int a = 0; a < 2; ++a)
#pragma unroll
        for (int b = 0; b < 2; ++b)
#pragma unroll
            for (int m = 0; m < 4; ++m)
#pragma unroll
                for (int n = 0; n < 2; ++n) acc[a][b][m][n] = (f32x4){0.f, 0.f, 0.f, 0.f};
    bf16x8 At[4][2], B0[2][2], B1[2][2];
    const char* const abase = S.a_base();
    const char* cB = S.b_ptr(cur);
    PG8_STAGE(PG8_SB(0, 0), cB, voffB); PG8_STAGE(PG8_SB(0, 1), cB + hstep, voffB); PG8_STAGE(PG8_SA(0, 0), abase, vcur[0]); PG8_STAGE(PG8_SA(0, 1), abase, vcur[1]);
    if (wr == 1) PG8_BAR;
    PG8_WAIT_V(2); PG8_BAR;
    PG8_STAGE(PG8_SB(1, 0), cB + kstep, voffB); PG8_STAGE(PG8_SA(1, 0), abase + kstep, vcur[0]); PG8_STAGE(PG8_SB(1, 1), cB + hstep + kstep, voffB);
    PG8_WAIT_V(6); PG8_BAR;
    for (;;) {
        const char* nB = has_next ? S.b_ptr(nxt) : cB;
        for (int t = 0; t < nt; t += 2) {
            const bool last = (t == nt - 2);
            const char* a1 = abase + (size_t)(t + 1) * kstep;
            const char* a2 = last ? abase : abase + (size_t)(t + 2) * kstep; const char* b2 = last ? nB : cB + (size_t)(t + 2) * kstep;
            const char* a3 = a2 + kstep; const char* b3 = b2 + kstep;
            unsigned v2[2][2];
#pragma unroll
            for (int h = 0; h < 2; ++h)
#pragma unroll
                for (int i = 0; i < 2; ++i) v2[h][i] = (last && has_next) ? vnxt[h][i] : vcur[h][i];
            PG8_LDB(B0, 0, 0); PG8_LDB(B1, 0, 1); PG8_SCHED; PG8_LDA(At, 0, 0); PG8_STAGE(PG8_SA(1, 1), a1, vcur[1]);
            PG8_WAIT_V(8); PG8_WAIT_L(0); PG8_BAR; PG8_MMA(0, 0, At, B0); PG8_MMA(0, 1, At, B1); PG8_BAR; PG8_SCHED;
            PG8_LDA(At, 0, 1); PG8_STAGE(PG8_SB(0, 0), b2, voffB); PG8_STAGE(PG8_SB(0, 1), b2 + hstep, voffB); PG8_STAGE(PG8_SA(0, 0), a2, v2[0]);
            PG8_WAIT_V(8); PG8_WAIT_L(0); PG8_BAR; PG8_MMA(1, 0, At, B0); PG8_MMA(1, 1, At, B1); PG8_BAR; PG8_SCHED;
            PG8_LDB(B0, 1, 0); PG8_LDB(B1, 1, 1); PG8_SCHED; PG8_LDA(At, 1, 0); PG8_STAGE(PG8_SA(0, 1), a2, v2[1]);
            PG8_WAIT_V(8); PG8_WAIT_L(0); PG8_BAR; PG8_MMA(0, 0, At, B0); PG8_MMA(0, 1, At, B1); PG8_BAR; PG8_SCHED;
            PG8_LDA(At, 1, 1); PG8_STAGE(PG8_SB(1, 0), b3, voffB); PG8_STAGE(PG8_SB(1, 1), b3 + hstep, voffB); PG8_STAGE(PG8_SA(1, 0), a3, v2[0]);
            PG8_WAIT_V(8); PG8_WAIT_L(0); PG8_BAR; PG8_MMA(1, 0, At, B0); PG8_MMA(1, 1, At, B1); PG8_BAR; PG8_SCHED;
        }
        if constexpr (ALIGN_EPI) { if (wr == 0) PG8_BAR; }
        const bool has_nx2 = has_next && S.next(ui + 2, nx2);
        unsigned raw[2][2];
#pragma unroll
        for (int h = 0; h < 2; ++h)
#pragma unroll
            for (int i = 0; i < 2; ++i) raw[h][i] = has_nx2 ? S.a_row(nx2, h * HALF + RA[i]) : 0u;
        E(acc, cur, wr, wc, fr, fq);
        if (!has_next) break;
#pragma unroll
        for (int a = 0; a < 2; ++a)
#pragma unroll
            for (int b = 0; b < 2; ++b)
#pragma unroll
                for (int m = 0; m < 4; ++m)
#pragma unroll
                    for (int n = 0; n < 2; ++n) acc[a][b][m][n] = (f32x4){0.f, 0.f, 0.f, 0.f};
#pragma unroll
        for (int h = 0; h < 2; ++h)
#pragma unroll
            for (int i = 0; i < 2; ++i) { vcur[h][i] = vnxt[h][i]; if (has_nx2) vnxt[h][i] = (raw[h][i] * (unsigned)K + (unsigned)CA[i]) * 2u; }
        cur = nxt; cB = nB; nxt = nx2; has_next = has_nx2; ++ui;
        if constexpr (ALIGN_EPI) { if (wr == 1) PG8_BAR; }
    }
    PG8_WAIT_V(0);
    if constexpr (!ALIGN_EPI) { if (wr == 0) PG8_BAR; }
    PG8_BAR;
#undef PG8_SA
#undef PG8_SB
#undef PG8_STAGE
#undef PG8_LDA
#undef PG8_LDB
#undef PG8_MMA
#undef PG8_WAIT_V
#undef PG8_WAIT_L
#undef PG8_BAR
#undef PG8_SCHED
}

struct EpiProj {
    static constexpr bool PERM = true;
    bf16* O;
    __device__ __forceinline__ void operator()(const f32x4 (&acc)[2][2][4][2], const Unit& u, int wr, int wc, int fr, int fq) const {
        const int row0 = u.T * BM + wr * 64 + fr, colt = u.pn * BM;
        const float sc = (colt < 512 || (colt >= 1536 && colt < 2048)) ? C2 : 1.0f;
        const int col0 = colt + wc * 32 + 8 * fq;
#pragma unroll
        for (int ai = 0; ai < 2; ++ai)
#pragma unroll
            for (int m = 0; m < 4; ++m) { bf16* rowp = O + (size_t)(row0 + ai * HALF + m * 16) * NIN + col0;
#pragma unroll
                for (int bj = 0; bj < 2; ++bj) { const f32x4 v0 = acc[ai][bj][m][0] * sc, v1 = acc[ai][bj][m][1] * sc;
                    u32x4 w; w.x = cvt_pk_bf16(v0[0], v0[1]); w.y = cvt_pk_bf16(v0[2], v0[3]); w.z = cvt_pk_bf16(v1[0], v1[1]); w.w = cvt_pk_bf16(v1[2], v1[3]);
                    *(u32x4*)(rowp + bj * HALF) = w; } }
    }
};
struct EpiResF32 {
    static constexpr bool PERM = false;
    const float* base; float* out;
    __device__ __forceinline__ void operator()(const f32x4 (&acc)[2][2][4][2], const Unit& u, int wr, int wc, int fr, int fq) const {
        const int col0 = u.pn * BM + wc * 32 + 4 * fq;
#pragma unroll
        for (int ai = 0; ai < 2; ++ai)
#pragma unroll
            for (int m = 0; m < 4; ++m) { const size_t off = (size_t)(u.T * BM + ai * HALF + wr * 64 + m * 16 + fr) * DM + col0;
#pragma unroll
                for (int bj = 0; bj < 2; ++bj)
#pragma unroll
                    for (int n = 0; n < 2; ++n) { f32x4 o = acc[ai][bj][m][n]; if (base) o += *(const f32x4*)(base + off + bj * HALF + n * 16); *(f32x4*)(out + off + bj * HALF + n * 16) = o; }
                if (m & 1) asm volatile("" ::: "memory"); }
    }
};
struct EpiGlu {
    static constexpr bool PERM = true;
    bf16* ACT; const float* bgu;
    __device__ __forceinline__ void operator()(const f32x4 (&acc)[2][2][4][2], const Unit& u, int wr, int wc, int fr, int fq) const {
        const int j0 = u.pn * HALF + wc * 32 + 8 * fq;
        const float* bp = bgu + (size_t)u.e * 2048 + 2 * j0;
        const f32x4 b0 = *(const f32x4*)(bp), b1 = *(const f32x4*)(bp + 4), b2 = *(const f32x4*)(bp + 8), b3 = *(const f32x4*)(bp + 12);
        const float bg[8] = {b0[0], b0[2], b1[0], b1[2], b2[0], b2[2], b3[0], b3[2]};
        const float bl[8] = {b0[1], b0[3], b1[1], b1[3], b2[1], b2[3], b3[1], b3[3]};
#pragma unroll
        for (int ai = 0; ai < 2; ++ai)
#pragma unroll
            for (int m = 0; m < 4; ++m) {
                const size_t row = (size_t)(u.T * BM + ai * HALF + wr * 64 + m * 16 + fr);
                float a[8];
#pragma unroll
                for (int i = 0; i < 8; ++i) {
                    const float g = fminf(acc[ai][0][m][i >> 2][i & 3] + bg[i], 7.0f);
                    const float l = fminf(fmaxf(acc[ai][1][m][i >> 2][i & 3] + bl[i], -7.0f), 7.0f);
                    a[i] = g * fast_sigmoid(1.702f * g) * (l + 1.0f);
                }
                u32x4 w; w.x = cvt_pk_bf16(a[0], a[1]); w.y = cvt_pk_bf16(a[2], a[3]); w.z = cvt_pk_bf16(a[4], a[5]); w.w = cvt_pk_bf16(a[6], a[7]);
                *(u32x4*)(ACT + row * DM + j0) = w;
            }
    }
};
struct EpiDown {
    static constexpr bool PERM = true;
    bf16* Y; const float* bdn; const float* lgate;
    __device__ __forceinline__ void operator()(const f32x4 (&acc)[2][2][4][2], const Unit& u, int wr, int wc, int fr, int fq) const {
        const int col0 = u.pn * BM + wc * 32 + 8 * fq;
        f32x4 bv[2][2];
#pragma unroll
        for (int bj = 0; bj < 2; ++bj)
#pragma unroll
            for (int n = 0; n < 2; ++n) bv[bj][n] = *(const f32x4*)(bdn + (size_t)u.e * DM + col0 + bj * HALF + 4 * n);
#pragma unroll
        for (int ai = 0; ai < 2; ++ai)
#pragma unroll
            for (int m = 0; m < 4; ++m) {
                const int rl = ai * HALF + wr * 64 + m * 16 + fr;
                const float g = lgate[(size_t)u.e * LCAP + u.pm * BM + rl];
                bf16* rowp = Y + (size_t)(u.T * BM + rl) * DM + col0;
#pragma unroll
                for (int bj = 0; bj < 2; ++bj) { const f32x4 v0 = (acc[ai][bj][m][0] + bv[bj][0]) * g, v1 = (acc[ai][bj][m][1] + bv[bj][1]) * g;
                    u32x4 w; w.x = cvt_pk_bf16(v0[0], v0[1]); w.y = cvt_pk_bf16(v0[2], v0[3]); w.z = cvt_pk_bf16(v1[0], v1[1]); w.w = cvt_pk_bf16(v1[2], v1[3]);
                    *(u32x4*)(rowp + bj * HALF) = w; } }
    }
};
struct EpiPle {
    static constexpr bool PERM = false;
    const float* h2; const bf16* pe; float* out;
    __device__ __forceinline__ void operator()(const f32x4 (&acc)[2][2][4][2], const Unit& u, int wr, int wc, int fr, int fq) const {
        const int col0 = u.pn * BM + wc * 32 + 4 * fq;
#pragma unroll
        for (int ai = 0; ai < 2; ++ai)
#pragma unroll
            for (int m = 0; m < 4; ++m) { const size_t off = (size_t)(u.T * BM + ai * HALF + wr * 64 + m * 16 + fr) * DM + col0;
#pragma unroll
                for (int bj = 0; bj < 2; ++bj)
#pragma unroll
                    for (int n = 0; n < 2; ++n) { const size_t o2 = off + bj * HALF + n * 16; const f32x4 hv = *(const f32x4*)(h2 + o2); const u32x2 pw = *(const u32x2*)(pe + o2); const f32x4 a = acc[ai][bj][m][n];
                        f32x4 o; o[0] = hv[0] + fast_sigmoid(a[0]) * bf_lo(pw.x); o[1] = hv[1] + fast_sigmoid(a[1]) * bf_hi(pw.x); o[2] = hv[2] + fast_sigmoid(a[2]) * bf_lo(pw.y); o[3] = hv[3] + fast_sigmoid(a[3]) * bf_hi(pw.y);
                        *(f32x4*)(out + o2) = o; }
                if (m & 1) asm volatile("" ::: "memory"); }
    }
};
}

namespace att {
constexpr int PITCH = NIN;
constexpr int STAGE = 24576;
constexpr int LDS_TBL = 2 * STAGE;
#define ATT_SBAR() __builtin_amdgcn_sched_barrier(0)
#define ATT_WAIT_BAR() asm volatile("s_waitcnt vmcnt(0) lgkmcnt(0)\n\ts_barrier" ::: "memory")
__device__ __forceinline__ int crow(int r, int hi) { return (r & 3) + 8 * (r >> 2) + 4 * hi; }
__device__ __forceinline__ void glds16(const void* gsrc, unsigned lds_dst) { unsigned keep;
    asm volatile("s_mov_b32 %0, m0\n\ts_mov_b32 m0, %2\n\ts_nop 0\n\tglobal_load_lds_dwordx4 %1, off\n\ts_mov_b32 m0, %0" : "=&s"(keep) : "v"(gsrc), "s"(lds_dst) : "memory"); }
__device__ __forceinline__ s16x4 vtr(const LAS unsigned char* p) { return __builtin_bit_cast(s16x4, __builtin_amdgcn_ds_read_tr16_b64_v4i16((LAS v4i16_t*)p)); }
__device__ __forceinline__ float partner_combine_max(float m) { auto rr = __builtin_amdgcn_permlane32_swap(__float_as_uint(m), __float_as_uint(m), false, false); return fmaxf(__uint_as_float(rr[0]), __uint_as_float(rr[1])); }
__device__ __forceinline__ float partner_combine_sum(float m) { auto rr = __builtin_amdgcn_permlane32_swap(__float_as_uint(m), __float_as_uint(m), false, false); return __uint_as_float(rr[0]) + __uint_as_float(rr[1]); }
__device__ __forceinline__ bf16x8 pack8(const f32x16& p, int b) {
    u32x4 w; w.x = cvt_pk_bf16(p[b], p[b + 1]); w.y = cvt_pk_bf16(p[b + 2], p[b + 3]); w.z = cvt_pk_bf16(p[b + 4], p[b + 5]); w.w = cvt_pk_bf16(p[b + 6], p[b + 7]);
    return __builtin_bit_cast(bf16x8, w);
}
__device__ __forceinline__ void dma_k(const bf16* Ktile, unsigned kdst, int wid, int lane) {
    glds16(Ktile + (size_t)lane * PITCH + wid * 8, (unsigned)__builtin_amdgcn_readfirstlane(kdst + wid * 1024));
}
template <int NVT> __device__ __forceinline__ void dma_v(const bf16* Vtile, unsigned vdst, int wid, int lane) {
#pragma unroll
    for (int q = 0; q < NVT / 2; ++q) { const int p = wid + 8 * q;
        glds16(Vtile + (size_t)(16 * (p & 3) + (lane >> 2)) * PITCH + (p >> 2) * 32 + (lane & 3) * 8, (unsigned)__builtin_amdgcn_readfirstlane(vdst + p * 1024)); }
}
__device__ __forceinline__ void qkt(f32x16& p0, f32x16& p1, const LAS unsigned char* kp, const bf16x8* qf) {
    p0 = f32x16{}; p1 = f32x16{};
#pragma unroll
    for (int d0 = 0; d0 < 4; ++d0) {
        const bf16x8 k0 = *(const LAS bf16x8*)(kp + d0 * 2048), k1 = *(const LAS bf16x8*)(kp + d0 * 2048 + 512);
        p0 = __builtin_amdgcn_mfma_f32_32x32x16_bf16(k0, qf[d0], p0, 0, 0, 0);
        p1 = __builtin_amdgcn_mfma_f32_32x32x16_bf16(k1, qf[d0], p1, 0, 0, 0);
    }
}
template <int NVT> __device__ __forceinline__ void pv(f32x16* o, const LAS unsigned char* vp, const f32x16& p0, const f32x16& p1) {
    const bf16x8 pf0 = pack8(p0, 0), pf1 = pack8(p0, 8), pf2 = pack8(p1, 0), pf3 = pack8(p1, 8);
#pragma unroll
    for (int nt = 0; nt < NVT; ++nt) {
#pragma unroll
        for (int s = 0; s < 4; ++s) {
            const s16x4 lo = vtr(vp + nt * 4096 + s * 1024), hi = vtr(vp + nt * 4096 + s * 1024 + 512);
            const bf16x8 vf = (bf16x8){lo[0], lo[1], lo[2], lo[3], hi[0], hi[1], hi[2], hi[3]};
            o[nt] = __builtin_amdgcn_mfma_f32_32x32x16_bf16(vf, s == 0 ? pf0 : s == 1 ? pf1 : s == 2 ? pf2 : pf3, o[nt], 0, 0, 0);
        }
    }
}

__device__ __forceinline__ float diff_map(f32x16* o, const bf16* Qw, const bf16* Kh, const bf16* Vh, int q0, int wid, int lane, LAS unsigned char* shm, const LAS float* tbl, float c31) {
    const int r32 = lane & 31, hi = lane >> 5;
    const unsigned lds0 = (unsigned)(uintptr_t)shm;
    bf16x8 qf[4];
#pragma unroll
    for (int d0 = 0; d0 < 4; ++d0) qf[d0] = *(const bf16x8*)(Qw + (size_t)r32 * PITCH + d0 * 16 + hi * 8);
#pragma unroll
    for (int d0 = 0; d0 < 4; ++d0) asm volatile("" : "+v"(qf[d0]));
#pragma unroll
    for (int nt = 0; nt < 4; ++nt) o[nt] = f32x16{};
    float mrun = -INFINITY, l = 0.f;
    const int NT = (q0 + 256) / 64;
    const int qlo = q0 + wid * 32, qrow = qlo + r32;
    const LAS unsigned char* kp0 = shm + hi * 1024 + r32 * 16;
    const LAS unsigned char* vp0 = shm + 8192 + ((lane >> 4) & 1) * 32 + (lane & 3) * 8 + (4 * hi + ((lane & 15) >> 2)) * 64;
    dma_k(Kh, lds0, wid, lane); dma_v<4>(Vh, lds0 + 8192, wid, lane);
    for (int t = 0; t < NT; ++t) {
        ATT_WAIT_BAR();
        const int st = (t & 1) * STAGE;
        if (t + 1 < NT) { const int sn = ((t + 1) & 1) * STAGE; dma_k(Kh + (size_t)(t + 1) * 64 * PITCH, lds0 + sn, wid, lane); dma_v<4>(Vh + (size_t)(t + 1) * 64 * PITCH, lds0 + sn + 8192, wid, lane); }
        const int k0 = t * 64;
        if (k0 > qlo + 31) continue;
        f32x16 p0, p1;
        qkt(p0, p1, kp0 + st, qf);
        if (qlo - (k0 + 63) >= 113) {
#pragma unroll
            for (int r = 0; r < 16; ++r) { p0[r] += c31; p1[r] += c31; }
        } else {
#pragma unroll
            for (int r = 0; r < 16; ++r) {
                const int rel0 = qrow - (k0 + crow(r, hi)), rel1 = rel0 - 32;
                const float b0 = tbl[rel0 < 0 ? 0 : (rel0 > 127 ? 127 : rel0)], b1 = tbl[rel1 < 0 ? 0 : (rel1 > 127 ? 127 : rel1)];
                p0[r] = rel0 < 0 ? -INFINITY : p0[r] + b0; p1[r] = rel1 < 0 ? -INFINITY : p1[r] + b1;
            }
        }
        float rm = fmaxf(p0[0], p1[0]);
#pragma unroll
        for (int r = 1; r < 16; ++r) rm = fmaxf(rm, fmaxf(p0[r], p1[r]));
        rm = partner_combine_max(rm);
        const float mn = fmaxf(mrun, rm);
        const float alpha = __builtin_amdgcn_exp2f(mrun - mn);
        mrun = mn; l *= alpha;
#pragma unroll
        for (int nt = 0; nt < 4; ++nt)
#pragma unroll
            for (int r = 0; r < 16; ++r) o[nt][r] *= alpha;
        float s = 0.f;
#pragma unroll
        for (int r = 0; r < 16; ++r) { p0[r] = __builtin_amdgcn_exp2f(p0[r] - mn); p1[r] = __builtin_amdgcn_exp2f(p1[r] - mn); s += p0[r] + p1[r]; }
        l += s;
        pv<4>(o, vp0 + st, p0, p1);
    }
    ATT_WAIT_BAR();
    return partner_combine_sum(l);
}

__device__ __forceinline__ void diff_unit(int b, int h, int qb, const bf16* PROJ, bf16* O, const float* rel_bias, const float* subln, float lam, LAS unsigned char* shm) {
    const int tid = threadIdx.x, lane = tid & 63, r32 = lane & 31, hi = lane >> 5; const int wid = __builtin_amdgcn_readfirstlane(tid >> 6);
    LAS float* tbl = (LAS float*)(shm + LDS_TBL);
    if (tid < 128) { const int n = tid; int bk = n;
        if (n >= 16) { bk = 16 + (n >= 19) + (n >= 21) + (n >= 24) + (n >= 27) + (n >= 31) + (n >= 35) + (n >= 40) + (n >= 46) + (n >= 52) + (n >= 59) + (n >= 67) + (n >= 77) + (n >= 87) + (n >= 99) + (n >= 113); }
        tbl[n] = rel_bias[bk * 4 + h] * LOG2E; }
    const float c31 = rel_bias[31 * 4 + h] * LOG2E;
    const int q0 = qb * 256; const size_t rowbase = (size_t)b * SEQ;
    const bf16* P0 = PROJ + rowbase * PITCH;
    const bf16* Qw1 = P0 + (size_t)(q0 + wid * 32) * PITCH + C_Q1 + h * 64;
    f32x16 o2[4]; u32x2 o1p[4][4][1];
    {
        f32x16 o1[4];
        const float l1 = diff_map(o1, Qw1, P0 + C_K1 + h * 64, P0 + C_DV + h * 128, q0, wid, lane, shm, tbl, c31);
        const float i1 = 1.0f / l1;
#pragma unroll
        for (int nt = 0; nt < 4; ++nt)
#pragma unroll
            for (int c = 0; c < 4; ++c) { o1p[nt][c][0].x = cvt_pk_bf16(o1[nt][4 * c] * i1, o1[nt][4 * c + 1] * i1); o1p[nt][c][0].y = cvt_pk_bf16(o1[nt][4 * c + 2] * i1, o1[nt][4 * c + 3] * i1); }
    }
    const float l2 = diff_map(o2, Qw1 + (C_Q2 - C_Q1), P0 + C_K2 + h * 64, P0 + C_DV + h * 128, q0, wid, lane, shm, tbl, c31);
    const float i2 = lam / l2;
    float ss = 0.f;
#pragma unroll
    for (int nt = 0; nt < 4; ++nt)
#pragma unroll
        for (int c = 0; c < 4; ++c) {
            const float a0 = bf_lo(o1p[nt][c][0].x) - o2[nt][4 * c] * i2, a1 = bf_hi(o1p[nt][c][0].x) - o2[nt][4 * c + 1] * i2, a2 = bf_lo(o1p[nt][c][0].y) - o2[nt][4 * c + 2] * i2, a3 = bf_hi(o1p[nt][c][0].y) - o2[nt][4 * c + 3] * i2;
            o2[nt][4 * c] = a0; o2[nt][4 * c + 1] = a1; o2[nt][4 * c + 2] = a2; o2[nt][4 * c + 3] = a3; ss += (a0 * a0 + a1 * a1) + (a2 * a2 + a3 * a3); }
    ss = partner_combine_sum(ss);
    const float rs = (1.0f - LAMBDA_INIT) / sqrtf(ss * (1.0f / 128.0f) + NORM_EPS);
    bf16* Ow = O + (rowbase + q0 + wid * 32 + r32) * DM + h * 128;
#pragma unroll
    for (int nt = 0; nt < 4; ++nt)
#pragma unroll
        for (int c = 0; c < 4; ++c) { const int n0 = 32 * nt + 8 * c + 4 * hi; const f32x4 g = *(const f32x4*)(subln + n0);
            u32x2 w; w.x = cvt_pk_bf16(o2[nt][4 * c] * rs * g[0], o2[nt][4 * c + 1] * rs * g[1]); w.y = cvt_pk_bf16(o2[nt][4 * c + 2] * rs * g[2], o2[nt][4 * c + 3] * rs * g[3]);
            *(u32x2*)(Ow + n0) = w; }
}

template <bool BAND> __device__ __forceinline__ void sb_sub(f32x16& p, float& R, int krel  , int hi) {
    float f[16];
#pragma unroll
    for (int r = 0; r < 16; ++r) {
        const float z = fmaxf(p[r], -100.0f);
        const float u = __builtin_amdgcn_exp2f(-z);
        float bt = __builtin_amdgcn_rcpf(1.0f + u);
        float ff = u * bt;
        if (BAND) { const bool masked = (krel - ((r & 3) + 8 * (r >> 2))) <= 0; bt = masked ? 0.f : bt; ff = masked ? 1.f : ff; }
        p[r] = bt; f[r] = ff;
    }
    float GP[4], PS[4];
#pragma unroll
    for (int c = 0; c < 4; ++c) { const float g = (f[4 * c] * f[4 * c + 1]) * (f[4 * c + 2] * f[4 * c + 3]);
        auto rr = __builtin_amdgcn_permlane32_swap(__float_as_uint(g), __float_as_uint(g), false, false);
        const float a0 = __uint_as_float(rr[0]), a1 = __uint_as_float(rr[1]);
        GP[c] = a0 * a1; PS[c] = hi ? 1.0f : a1; }
    float T = R;
#pragma unroll
    for (int c = 3; c >= 0; --c) {
        const float base = T * PS[c];
        const float s3 = base, s2 = s3 * f[4 * c + 3], s1 = s2 * f[4 * c + 2], s0 = s1 * f[4 * c + 1];
        p[4 * c + 3] *= s3; p[4 * c + 2] *= s2; p[4 * c + 1] *= s1; p[4 * c] *= s0;
        T *= GP[c];
    }
    R = T;
}

__device__ __forceinline__ void sb_unit(int b, int h, int qb, const bf16* PROJ, bf16* O, LAS unsigned char* shm) {
    const int tid = threadIdx.x, lane = tid & 63, r32 = lane & 31, hi = lane >> 5; const int wid = __builtin_amdgcn_readfirstlane(tid >> 6);
    const unsigned lds0 = (unsigned)(uintptr_t)shm;
    const int q0 = qb * 256; const size_t rowbase = (size_t)b * SEQ;
    const bf16* P0 = PROJ + rowbase * PITCH;
    const bf16* Qw = P0 + (size_t)(q0 + wid * 32) * PITCH + C_SQ + h * 64;
    const bf16* Kh = P0 + C_SK + h * 64; const bf16* Vh = P0 + C_SV + h * 64;
    bf16x8 qf[4];
#pragma unroll
    for (int d0 = 0; d0 < 4; ++d0) qf[d0] = *(const bf16x8*)(Qw + (size_t)r32 * PITCH + d0 * 16 + hi * 8);
#pragma unroll
    for (int d0 = 0; d0 < 4; ++d0) asm volatile("" : "+v"(qf[d0]));
    f32x16 o[2]; o[0] = f32x16{}; o[1] = f32x16{};
    float R = 1.0f;
    const int NT = (q0 + 256) / 64;
    const int qlo = q0 + wid * 32, qrow = qlo + r32;
    const LAS unsigned char* kp0 = shm + hi * 1024 + r32 * 16;
    const LAS unsigned char* vp0 = shm + 8192 + ((lane >> 4) & 1) * 32 + (lane & 3) * 8 + (4 * hi + ((lane & 15) >> 2)) * 64;
    dma_k(Kh + (size_t)(NT - 1) * 64 * PITCH, lds0 + ((NT - 1) & 1) * STAGE, wid, lane); dma_v<2>(Vh + (size_t)(NT - 1) * 64 * PITCH, lds0 + ((NT - 1) & 1) * STAGE + 8192, wid, lane);
    for (int t = NT - 1; t >= 0; --t) {
        ATT_WAIT_BAR();
        const int st = (t & 1) * STAGE;
        if (t > 0) { const int sn = ((t - 1) & 1) * STAGE; dma_k(Kh + (size_t)(t - 1) * 64 * PITCH, lds0 + sn, wid, lane); dma_v<2>(Vh + (size_t)(t - 1) * 64 * PITCH, lds0 + sn + 8192, wid, lane); }
        const int k0 = t * 64;
        if (k0 >= qlo + 31) continue;
        f32x16 p0, p1;
        qkt(p0, p1, kp0 + st, qf);
        const int krel = qrow - (k0 + 4 * hi);
        if (k0 + 63 >= qlo) { sb_sub<true>(p1, R, krel - 32, hi); sb_sub<true>(p0, R, krel, hi); }
        else { sb_sub<false>(p1, R, 0, hi); sb_sub<false>(p0, R, 0, hi); }
        pv<2>(o, vp0 + st, p0, p1);
    }
    ATT_WAIT_BAR();
    bf16* Ow = O + (rowbase + qrow) * DM + 512 + h * 64;
#pragma unroll
    for (int nt = 0; nt < 2; ++nt)
#pragma unroll
        for (int c = 0; c < 4; ++c) { const int n0 = 32 * nt + 8 * c + 4 * hi;
            u32x2 w; w.x = cvt_pk_bf16(o[nt][4 * c], o[nt][4 * c + 1]); w.y = cvt_pk_bf16(o[nt][4 * c + 2], o[nt][4 * c + 3]);
            *(u32x2*)(Ow + n0) = w; }
}
#undef ATT_SBAR
}

#define XB_TMO      128
#define XB_XCNT(j)  (256  + 64 * (j))
#define XB_XSUB(j)  (1280 + 64 * (j))
#define XB_XGEN(j)  (2304 + 64 * (j))
#define XB_TOP      3328
#define XB_TOPGEN   3392
#define XCD_BAR_WORDS 3456
#define XB_SPIN_CAP (1u << 18)
__device__ __forceinline__ unsigned xb_ld(unsigned* p)              { return __hip_atomic_load(p, __ATOMIC_RELAXED, __HIP_MEMORY_SCOPE_AGENT); }
__device__ __forceinline__ unsigned xb_add(unsigned* p, unsigned v) { return __hip_atomic_fetch_add(p, v, __ATOMIC_RELAXED, __HIP_MEMORY_SCOPE_AGENT); }
__device__ __forceinline__ unsigned xb_xcc_id() { return (unsigned)__builtin_amdgcn_s_getreg((3 << 11) | 20) & 0xFu; }
#define XB_SPIN(cond, bar) do { unsigned _sp = 0; while (cond) { __builtin_amdgcn_s_sleep(1); \
    if ((++_sp & 255u) == 0u) { if (xb_ld(&(bar)[XB_TMO])) break; if (_sp > XB_SPIN_CAP) { atomicAdd(&(bar)[XB_TMO], 1u); break; } } } } while (0)
struct XcdBarrier { unsigned* bar; unsigned x; volatile LAS unsigned* st; };
__device__ __forceinline__ XcdBarrier xcd_barrier_post(unsigned* bar, volatile LAS unsigned* st) {
    XcdBarrier b; b.bar = bar; b.x = xb_xcc_id(); b.st = st;
    if (threadIdx.x == 0) (void)xb_add(&bar[XB_XCNT(b.x)], 1u);
    return b;
}
__device__ __forceinline__ void xcd_barrier_complete(unsigned* bar, unsigned x, unsigned& nloc, unsigned& nx) {
    const unsigned G = gridDim.x * gridDim.y * gridDim.z;
    unsigned sum, cnt, mine, sp = 0u;
    for (;;) {
        sum = 0u; cnt = 0u; mine = 0u;
#pragma unroll
        for (unsigned j = 0; j < 16; ++j) { const unsigned c = xb_ld(&bar[XB_XCNT(j)]); sum += c; cnt += (c > 0u) ? 1u : 0u; mine = (j == x) ? c : mine; }
        if (sum == G) break;
        __builtin_amdgcn_s_sleep(1);
        if ((++sp & 255u) == 0u) { if (xb_ld(&bar[XB_TMO])) break; if (sp > XB_SPIN_CAP) { atomicAdd(&bar[XB_TMO], 1u); break; } }
    }
    nloc = mine > 0u ? mine : 1u; nx = cnt > 0u ? cnt : 1u;
}
__device__ __forceinline__ void xcd_barrier(const XcdBarrier& b) {
    asm volatile("s_waitcnt vmcnt(0)" ::: "memory");
    __syncthreads();
    if (threadIdx.x == 0) {
        unsigned* bar = b.bar;
        __builtin_amdgcn_s_waitcnt(0);
        unsigned nloc = b.st[0], nx = b.st[1];
        if (nloc == 0u) { xcd_barrier_complete(bar, b.x, nloc, nx); b.st[0] = nloc; b.st[1] = nx; }
        const unsigned old = xb_add(&bar[XB_XSUB(b.x)], 1u);
        const unsigned gen = old / nloc;
        if (old + 1u == (gen + 1u) * nloc) {
            __builtin_amdgcn_fence(__ATOMIC_RELEASE, "agent");
            asm volatile("s_waitcnt vmcnt(0)" ::: "memory");
            const unsigned og = xb_add(&bar[XB_TOP], 1u);
            const unsigned tg = og / nx;
            if (og + 1u == (tg + 1u) * nx) xb_add(&bar[XB_TOPGEN], 1u);
            else XB_SPIN(xb_ld(&bar[XB_TOPGEN]) == tg, bar);
            __builtin_amdgcn_fence(__ATOMIC_ACQUIRE, "agent");
            xb_add(&bar[XB_XGEN(b.x)], 1u);
            asm volatile("s_waitcnt vmcnt(0)" ::: "memory");
        } else {
            XB_SPIN(xb_ld(&bar[XB_XGEN(b.x)]) == gen, bar);
            __builtin_amdgcn_fence(__ATOMIC_ACQUIRE, "agent");
            asm volatile("s_waitcnt vmcnt(0)" ::: "memory");
        }
    }
    __syncthreads();
}

struct Args {
    const float *x, *p, *w_in, *w_out, *attn_norm, *moe_norm, *rel_bias, *lq1, *lk1, *lq2, *lk2, *subln, *router_w, *router_b, *w_gu, *b_gu, *w_dn, *b_dn, *ple_proj, *ple_norm, *ple_gate, *final_norm;
    float* out; unsigned char* ws; int ph_lo, ph_hi;
};

template <bool GLU> __device__ __forceinline__ void p0_transpose_item(const float* W, int K, int N, bf16* WT, LAS float* scr, int item, int lane) {
    const int nblk = N / 32, kb = item / nblk, nb = item % nblk, k0 = 64 * kb, n0 = 32 * nb;
#pragma unroll 8
    for (int i = 0; i < 32; ++i) { const int kk = 2 * i + (lane >> 5); scr[kk * 33 + (lane & 31)] = W[(size_t)(k0 + kk) * N + n0 + (lane & 31)]; }
    LDS_WAIT(); asm volatile("" ::: "memory");
    const int c = lane & 7;
#pragma unroll
    for (int j = 0; j < 4; ++j) { const int n = (lane >> 3) + 8 * j; const LAS float* s = scr + (8 * c) * 33 + n;
        v4u o; o.x = pk2(s[0 * 33], s[1 * 33]); o.y = pk2(s[2 * 33], s[3 * 33]); o.z = pk2(s[4 * 33], s[5 * 33]); o.w = pk2(s[6 * 33], s[7 * 33]);
        int nn = n0 + n; if (GLU) { const int jj = nn >> 1; nn = 256 * (jj >> 7) + 128 * (nn & 1) + (jj & 127); }
        *(GAS v4u*)(WT + (size_t)nn * K + k0 + 8 * c) = o; }
    LDS_WAIT(); asm volatile("" ::: "memory");
}
__device__ __forceinline__ void rms_row_to_bf16(const float* xrow, const float* gain, bf16* orow, int lane) {
    const GAS f32x4* xr = (const GAS f32x4*)xrow + lane; const GAS f32x4* gr = (const GAS f32x4*)gain + lane;
    f32x4 v[4]; float s = 0.f;
#pragma unroll
    for (int j = 0; j < 4; ++j) { v[j] = xr[64 * j]; s += (v[j].x * v[j].x + v[j].y * v[j].y) + (v[j].z * v[j].z + v[j].w * v[j].w); }
    const float rstd = 1.f / sqrtf(wave_sum(s) * (1.f / DM) + NORM_EPS);
    GAS unsigned long long* o8 = (GAS unsigned long long*)orow + lane;
#pragma unroll
    for (int j = 0; j < 4; ++j) { const f32x4 g = gr[64 * j]; o8[64 * j] = (unsigned long long)pk2(v[j].x * rstd * g.x, v[j].y * rstd * g.y) | ((unsigned long long)pk2(v[j].z * rstd * g.z, v[j].w * rstd * g.w) << 32); }
}

__global__ void __launch_bounds__(NWAVES * 64, 2) mk_fwd(Args args) {
    extern __shared__ __attribute__((aligned(16))) unsigned char lds_raw[];
    LAS unsigned char* const lds = (LAS unsigned char*)lds_raw;
    volatile LAS unsigned* const MISC = (volatile LAS unsigned*)(lds + MISC_OFF);
    const int tid = threadIdx.x, lane = tid & 63, wave = __builtin_amdgcn_readfirstlane(tid >> 6);
    const int G = gridDim.x; const int bx = blockIdx.x; const int vcu = (G % 8 == 0) ? (bx % 8) * (G / 8) + bx / 8 : bx;
    unsigned char* const ws = args.ws;
    gu32* const ctl = (gu32*)(ws + WS_CTL);
    bf16* const Win_t = (bf16*)(ws + WS_WIN); bf16* const Wout_t = (bf16*)(ws + WS_WOUT); bf16* const Wpg_t = (bf16*)(ws + WS_WPG); bf16* const Wpp_t = (bf16*)(ws + WS_WPP);
    bf16* const Wgu_t = (bf16*)(ws + WS_WGU); bf16* const Wdn_t = (bf16*)(ws + WS_WDN);
    bf16* const XN = (bf16*)(ws + WS_XN); bf16* const OB = (bf16*)(ws + WS_O); bf16* const PROJ = (bf16*)(ws + WS_PROJ);
    float* const H1 = (float*)(ws + WS_H1); float* const PERAW = (float*)(ws + WS_PERAW); bf16* const PE16 = (bf16*)(ws + WS_PE16); bf16* const P16 = (bf16*)(ws + WS_P16);
    bf16* const ACT = (bf16*)(ws + WS_ACT); bf16* const YB = (bf16*)(ws + WS_Y);
    int* const TINFO = (int*)(ws + WS_TINFO); int* const LIST = (int*)(ws + WS_LIST); float* const LGATE = (float*)(ws + WS_LGATE);

    for (int u = tid; u < (LDS_BYTES - MISC_OFF) / 4; u += NWAVES * 64) ((LAS unsigned*)(lds + MISC_OFF))[u] = 0u;
    __syncthreads();
    XcdBarrier bar; bar.bar = (unsigned*)(ctl + CW_BAR); bar.x = 0; bar.st = nullptr;
    if (MK_N_LAUNCHES == 1) bar = xcd_barrier_post((unsigned*)(ctl + CW_BAR), MISC + 8);
    const int lo = args.ph_lo, hi = args.ph_hi;
#define IN(k) (lo <= (k) && (k) < hi)
#define SEAM(k) do { if (IN(k) && IN((k) + 1)) xcd_barrier(bar); } while (0)

    if (IN(0)) {
        LAS float* scr = (LAS float*)(lds + wave * 16384);
        const int gw = vcu * NWAVES + wave, NGW = G * NWAVES;
        constexpr int I_IN = (DM / 64) * (NIN / 32), I_SQ = (DM / 64) * (DM / 32), I_PP = (PLE / 64) * (DM / 32), I_GU = (DM / 64) * (2048 / 32);
        constexpr int NITEMS = I_IN + 2 * I_SQ + I_PP + NEXP * I_GU + NEXP * I_SQ;
        for (int it = gw; it < NITEMS; it += NGW) {
            int r = it;
            if (r < I_IN) { p0_transpose_item<false>(args.w_in, DM, NIN, Win_t, scr, r, lane); continue; } r -= I_IN;
            if (r < I_SQ) { p0_transpose_item<false>(args.w_out, DM, DM, Wout_t, scr, r, lane); continue; } r -= I_SQ;
            if (r < I_SQ) { p0_transpose_item<false>(args.ple_gate, DM, DM, Wpg_t, scr, r, lane); continue; } r -= I_SQ;
            if (r < I_PP) { p0_transpose_item<false>(args.ple_proj, PLE, DM, Wpp_t, scr, r, lane); continue; } r -= I_PP;
            if (r < NEXP * I_GU) { const int e = r / I_GU; p0_transpose_item<true>(args.w_gu + (size_t)e * DM * 2048, DM, 2048, Wgu_t + (size_t)e * 2048 * DM, scr, r % I_GU, lane); continue; } r -= NEXP * I_GU;
            { const int e = r / I_SQ; p0_transpose_item<false>(args.w_dn + (size_t)e * DM * DM, DM, DM, Wdn_t + (size_t)e * DM * DM, scr, r % I_SQ, lane); }
        }
        for (int m = gw; m < M; m += NGW) {
            rms_row_to_bf16(args.x + (size_t)m * DM, args.attn_norm, XN + (size_t)m * DM, lane);
            const f32x4 pv4 = *((const GAS f32x4*)(args.p + (size_t)m * PLE) + lane);
            *((GAS unsigned long long*)(P16 + (size_t)m * PLE) + lane) = (unsigned long long)pk2(pv4.x, pv4.y) | ((unsigned long long)pk2(pv4.z, pv4.w) << 32);
        }
    }
    SEAM(0);

    if (IN(1)) {
        pg8::DenseOrder S; S.init(XN, Win_t, M, NIN, DM, G, bx);
        pg8::EpiProj E{PROJ};
        pg8::gemm_phase<pg8::EpiProj, pg8::DenseOrder, true>(lds, S, E);
    }
    SEAM(1);

    if (IN(2)) {
        float lam;
        { const float a = wave_sum(args.lq1[lane] * args.lk1[lane]), c = wave_sum(args.lq2[lane] * args.lk2[lane]); lam = expf(a) - expf(c) + LAMBDA_INIT; }
        for (;;) {
            if (tid == 0) MISC[16] = __hip_atomic_fetch_add(ctl + CW_ATTQ, 1u, RLX_AGENT);
            __syncthreads();
            const int u = (int)MISC[16];
            __syncthreads();
            if (u >= 768) break;
            const int qb = 7 - u / 96, g = u % 96;
            if (g < 32) att::diff_unit(g >> 2, g & 3, qb, PROJ, OB, args.rel_bias, args.subln, lam, lds);
            else att::sb_unit((g - 32) >> 3, (g - 32) & 7, qb, PROJ, OB, lds);
        }
    }
    SEAM(2);

    if (IN(3)) {
        { pg8::DenseOrder S; S.init(OB, Wout_t, M, DM, DM, G, bx); pg8::EpiResF32 E{args.x, H1};
          pg8::gemm_phase<pg8::EpiResF32, pg8::DenseOrder, false>(lds, S, E); }
        if (MK_PIPE >= 3) { pg8::DenseOrder S; S.init(P16, Wpp_t, M, DM, PLE, G, bx); pg8::EpiResF32 E{nullptr, PERAW};
          pg8::gemm_phase<pg8::EpiResF32, pg8::DenseOrder, false>(lds, S, E); }
    }
    SEAM(3);

    if (IN(4) && MK_PIPE >= 2) {
        LAS float* xs = (LAS float*)(lds + wave * 16384);
        LAS int* lcnt = (LAS int*)(lds + TAB_OFF + 512);
        LAS int* lbase = lcnt + 32;
        LAS int* pend = (LAS int*)(lds + TAB_OFF + 1024);
        for (int tile = bx; tile < M / 64; tile += G) {
            if (tid < 32) lcnt[tid] = 0;
            __syncthreads();
            for (int pass = 0; pass < 2; ++pass) {
                const int row0 = tile * 64 + wave * 8 + pass * 4;
#pragma unroll 1
                for (int r = 0; r < 4; ++r) {
                    const int m = row0 + r;
                    const GAS f32x4* xr = (const GAS f32x4*)(H1 + (size_t)m * DM) + lane; const GAS f32x4* gr = (const GAS f32x4*)args.moe_norm + lane;
                    f32x4 v[4]; float s = 0.f;
#pragma unroll
                    for (int j = 0; j < 4; ++j) { v[j] = xr[64 * j]; s += (v[j].x * v[j].x + v[j].y * v[j].y) + (v[j].z * v[j].z + v[j].w * v[j].w); }
                    const float rstd = 1.f / sqrtf(wave_sum(s) * (1.f / DM) + NORM_EPS);
                    GAS unsigned long long* o8 = (GAS unsigned long long*)(XN + (size_t)m * DM) + lane;
#pragma unroll
                    for (int j = 0; j < 4; ++j) { const f32x4 g = gr[64 * j]; const f32x4 y = (f32x4){v[j].x * rstd * g.x, v[j].y * rstd * g.y, v[j].z * rstd * g.z, v[j].w * rstd * g.w};
                        o8[64 * j] = (unsigned long long)pk2(y.x, y.y) | ((unsigned long long)pk2(y.z, y.w) << 32);
                        const int kb = 4 * lane + 256 * j;
                        xs[(kb + 0) * 4 + r] = y.x; xs[(kb + 1) * 4 + r] = y.y; xs[(kb + 2) * 4 + r] = y.z; xs[(kb + 3) * 4 + r] = y.w; }
                }
                LDS_WAIT(); asm volatile("" ::: "memory");
                const int e = lane & 31, kh = lane >> 5;
                float a0 = 0.f, a1 = 0.f, a2 = 0.f, a3 = 0.f;
                const float* wp = args.router_w + (size_t)(kh * 512) * NEXP + e;
                const LAS f32x4* xp = (const LAS f32x4*)xs + kh * 512;
#pragma unroll 8
                for (int k = 0; k < 512; ++k) { const float w = wp[(size_t)k * NEXP]; const f32x4 xv = xp[k]; a0 += w * xv.x; a1 += w * xv.y; a2 += w * xv.z; a3 += w * xv.w; }
                a0 += __shfl_xor(a0, 32); a1 += __shfl_xor(a1, 32); a2 += __shfl_xor(a2, 32); a3 += __shfl_xor(a3, 32);
                const float rb = args.router_b[e];
                float lg[4] = {a0 + rb, a1 + rb, a2 + rb, a3 + rb};
#pragma unroll
                for (int r = 0; r < 4; ++r) {
                    float v = lg[r]; float tv[4]; int ti[4];
#pragma unroll
                    for (int k = 0; k < 4; ++k) {
                        float bv = v; int bi = e;
#pragma unroll
                        for (int o = 1; o < 32; o <<= 1) { const float ov = __shfl_xor(bv, o); const int oi = __shfl_xor(bi, o); if (ov > bv || (ov == bv && oi < bi)) { bv = ov; bi = oi; } }
                        tv[k] = bv; ti[k] = bi; if (e == bi) v = -INFINITY;
                    }
                    const float e1 = __expf(tv[1] - tv[0]), e2 = __expf(tv[2] - tv[0]), e3 = __expf(tv[3] - tv[0]); const float inv = 1.0f / (1.0f + e1 + e2 + e3);
                    if (lane < 4) { const int k = lane; const int ek = k == 0 ? ti[0] : k == 1 ? ti[1] : k == 2 ? ti[2] : ti[3]; const float gk = (k == 0 ? 1.0f : k == 1 ? e1 : k == 2 ? e2 : e3) * inv;
                        const int rank = __hip_atomic_fetch_add(lcnt + ek, 1, __ATOMIC_RELAXED, __HIP_MEMORY_SCOPE_WORKGROUP);
                        const int pi = ((wave * 2 + pass) * 4 + r) * 4 + k;
                        pend[pi * 4 + 0] = (row0 + r) * 4 + k; pend[pi * 4 + 1] = ek; pend[pi * 4 + 2] = rank; pend[pi * 4 + 3] = (int)__float_as_uint(gk); }
                }
                LDS_WAIT(); asm volatile("" ::: "memory");
            }
            __syncthreads();
            if (tid < 32) { const int c = lcnt[tid]; lbase[tid] = c > 0 ? (int)__hip_atomic_fetch_add(ctl + CW_GCNT + 64 * tid, (unsigned)c, RLX_AGENT) : 0; }
            __syncthreads();
            if (tid < 256) { const int tk = pend[tid * 4 + 0], ek = pend[tid * 4 + 1], rank = pend[tid * 4 + 2]; const float gk = __uint_as_float((unsigned)pend[tid * 4 + 3]);
                const int pos = lbase[ek] + rank;
                LIST[ek * LCAP + pos] = tk >> 2; LGATE[ek * LCAP + pos] = gk; TINFO[tk] = (pos << 5) | ek; }
            __syncthreads();
        }
    }
    SEAM(4);

    LAS int* const tp = (LAS int*)(lds + TAB_OFF); LAS int* const ecnt = tp + 40;
    if ((IN(5) || IN(6) || IN(7)) && MK_PIPE >= 2) {
        if (tid < 32) ecnt[tid] = (int)__hip_atomic_load(ctl + CW_GCNT + 64 * tid, RLX_AGENT);
        __syncthreads();
        if (tid == 0) { int a = 0; for (int e = 0; e < NEXP; ++e) { tp[e] = a; a += (ecnt[e] + 255) >> 8; } tp[NEXP] = a; }
        __syncthreads();
    }

    if (IN(5) && MK_PIPE >= 2) {
        pg8::GroupedOrder<true, 8, 4> S{XN, Wgu_t, (size_t)2048 * DM * 2, LIST, tp, ecnt, DM, G, bx};
        pg8::EpiGlu E{ACT, args.b_gu};
        pg8::gemm_phase<pg8::EpiGlu, pg8::GroupedOrder<true, 8, 4>, true>(lds, S, E);
    }
    SEAM(5);

    if (IN(6) && MK_PIPE >= 2) {
        pg8::GroupedOrder<false, 4, 8> S{ACT, Wdn_t, (size_t)DM * DM * 2, LIST, tp, ecnt, DM, G, bx};
        pg8::EpiDown E{YB, args.b_dn, LGATE};
        pg8::gemm_phase<pg8::EpiDown, pg8::GroupedOrder<false, 4, 8>, true>(lds, S, E);
    }
    SEAM(6);

    if (IN(7) && MK_PIPE >= 2) {
        const int gw = vcu * NWAVES + wave, NGW = G * NWAVES;
        for (int m = gw; m < M; m += NGW) {
            GAS f32x4* hr = (GAS f32x4*)(H1 + (size_t)m * DM) + lane;
            f32x4 v[4];
#pragma unroll
            for (int j = 0; j < 4; ++j) v[j] = hr[64 * j];
#pragma unroll
            for (int k = 0; k < 4; ++k) { const int ti = TINFO[m * 4 + k]; const int e = ti & 31, pos = ti >> 5; const size_t slot = (size_t)tp[e] * 256 + pos;
                const GAS u32x2* yr = (const GAS u32x2*)(YB + slot * DM) + lane;
#pragma unroll
                for (int j = 0; j < 4; ++j) { const u32x2 w = yr[64 * j]; v[j].x += bf_lo(w.x); v[j].y += bf_hi(w.x); v[j].z += bf_lo(w.y); v[j].w += bf_hi(w.y); } }
            GAS unsigned long long* o8 = (GAS unsigned long long*)(XN + (size_t)m * DM) + lane;
#pragma unroll
            for (int j = 0; j < 4; ++j) { hr[64 * j] = v[j]; o8[64 * j] = (unsigned long long)pk2(v[j].x, v[j].y) | ((unsigned long long)pk2(v[j].z, v[j].w) << 32); }
            if (MK_PIPE >= 3) rms_row_to_bf16(PERAW + (size_t)m * DM, args.ple_norm, PE16 + (size_t)m * DM, lane);
        }
    }
    SEAM(7);

    if (IN(8) && MK_PIPE >= 3) {
        pg8::DenseOrder S; S.init(XN, Wpg_t, M, DM, DM, G, bx);
        pg8::EpiPle E{H1, PE16, args.out};
        pg8::gemm_phase<pg8::EpiPle, pg8::DenseOrder, false>(lds, S, E);
    }
    SEAM(8);

    if (IN(9)) {
        const int gw = vcu * NWAVES + wave, NGW = G * NWAVES;
        const float* src = (MK_PIPE >= 3) ? args.out : H1;
        for (int m = gw; m < M; m += NGW) {
            const GAS f32x4* xr = (const GAS f32x4*)(src + (size_t)m * DM) + lane; const GAS f32x4* gr = (const GAS f32x4*)args.final_norm + lane;
            f32x4 v[4]; float s = 0.f;
#pragma unroll
            for (int j = 0; j < 4; ++j) { v[j] = xr[64 * j]; s += (v[j].x * v[j].x + v[j].y * v[j].y) + (v[j].z * v[j].z + v[j].w * v[j].w); }
            const float rstd = 1.f / sqrtf(wave_sum(s) * (1.f / DM) + NORM_EPS);
            GAS f32x4* orow = (GAS f32x4*)(args.out + (size_t)m * DM) + lane;
#pragma unroll
            for (int j = 0; j < 4; ++j) { const f32x4 g = gr[64 * j]; orow[64 * j] = (f32x4){v[j].x * rstd * g.x, v[j].y * rstd * g.y, v[j].z * rstd * g.z, v[j].w * rstd * g.w}; }
        }
    }
#undef IN
#undef SEAM
}

extern "C" void kernel_launch(void* const* d_in, const int* in_sizes, int n_in, void* d_out, int out_size, void* d_ws, size_t ws_size, hipStream_t stream) {
    static int grid = 0;
    if (grid == 0) {
        if (n_in != 22 || in_sizes[0] != M * DM || out_size != M * DM || ws_size < WS_END) { fprintf(stderr, "kernel_launch: unexpected shapes (n_in %d, in0 %d, out %d, ws %zu); nothing launched\n", n_in, n_in > 0 ? in_sizes[0] : -1, out_size, ws_size); grid = -1; return; }
        int dev = 0, cus = 0, per_cu = 0;
        if (hipGetDevice(&dev) != hipSuccess || hipDeviceGetAttribute(&cus, hipDeviceAttributeMultiprocessorCount, dev) != hipSuccess) { grid = -1; return; }
        if (hipFuncSetAttribute((const void*)mk_fwd, hipFuncAttributeMaxDynamicSharedMemorySize, LDS_BYTES) != hipSuccess) { fprintf(stderr, "kernel_launch: hipFuncSetAttribute failed\n"); grid = -1; return; }
        if (hipOccupancyMaxActiveBlocksPerMultiprocessor(&per_cu, (const void*)mk_fwd, NWAVES * 64, LDS_BYTES) != hipSuccess || per_cu < 1) fprintf(stderr, "kernel_launch: occupancy query reports %d\n", per_cu);
        (void)hipGetLastError();
        grid = cus;
        if (grid != 256) { fprintf(stderr, "kernel_launch: built for a 256-CU device, found %d CUs; nothing launched\n", cus); grid = -1; return; }
    }
    if (grid < 0) return;
    if (hipMemsetAsync((char*)d_ws + WS_CTL, 0, CTL_ZERO_BYTES, stream) != hipSuccess) return;
    Args a{};
    a.x = (const float*)d_in[0]; a.p = (const float*)d_in[1]; a.w_in = (const float*)d_in[2]; a.w_out = (const float*)d_in[3]; a.attn_norm = (const float*)d_in[4]; a.moe_norm = (const float*)d_in[5];
    a.rel_bias = (const float*)d_in[6]; a.lq1 = (const float*)d_in[7]; a.lk1 = (const float*)d_in[8]; a.lq2 = (const float*)d_in[9]; a.lk2 = (const float*)d_in[10]; a.subln = (const float*)d_in[11];
    a.router_w = (const float*)d_in[12]; a.router_b = (const float*)d_in[13]; a.w_gu = (const float*)d_in[14]; a.b_gu = (const float*)d_in[15]; a.w_dn = (const float*)d_in[16]; a.b_dn = (const float*)d_in[17];
    a.ple_proj = (const float*)d_in[18]; a.ple_norm = (const float*)d_in[19]; a.ple_gate = (const float*)d_in[20]; a.final_norm = (const float*)d_in[21];
    a.out = (float*)d_out; a.ws = (unsigned char*)d_ws;
    for (int li = 0; li < MK_N_LAUNCHES; ++li) {
        a.ph_lo = (MK_N_LAUNCHES == 1) ? 0 : li; a.ph_hi = (MK_N_LAUNCHES == 1) ? N_PHASES : li + 1;
        hipLaunchKernelGGL(mk_fwd, dim3(grid), dim3(NWAVES * 64), LDS_BYTES, stream, a);
        const hipError_t le = hipPeekAtLastError();
        if (le != hipSuccess) { fprintf(stderr, "kernel_launch: launch %d failed: %s\n", li, hipGetErrorName(le)); break; }
    }
}
```

```cpp
#include <hip/hip_runtime.h>
#include <cstdio>
#include <cstdint>

#ifndef MK_N_LAUNCHES
#define MK_N_LAUNCHES 1
#endif
#ifndef MK_PIPE
#define MK_PIPE 3
#endif

#ifndef MK_REP
#define MK_REP -1
#endif
#define LAS __attribute__((address_space(3)))
#define GAS __attribute__((address_space(1)))
typedef unsigned short bf16;
typedef short bf16x8 __attribute__((ext_vector_type(8)));
typedef short s16x4 __attribute__((ext_vector_type(4)));
typedef short v4i16_t __attribute__((ext_vector_type(4)));
typedef float f32x2 __attribute__((ext_vector_type(2)));
typedef float f32x4 __attribute__((ext_vector_type(4)));
typedef float f32x16 __attribute__((ext_vector_type(16)));
typedef unsigned u32x2 __attribute__((ext_vector_type(2)));
typedef unsigned u32x4 __attribute__((ext_vector_type(4)));
typedef unsigned v4u __attribute__((ext_vector_type(4)));
typedef GAS unsigned gu32;

constexpr int NBATCH = 8, SEQ = 2048, DM = 1024, M = NBATCH * SEQ, NIN = 3072, NEXP = 32, TOPK = 4, PLE = 256;
constexpr int LCAP = 16384;
constexpr int MAXTILES = 288;
constexpr float NORM_EPS = 1e-6f;
constexpr float LOG2E = 1.4426950408889634f;
constexpr float C2 = 0.125f * LOG2E;
constexpr float LAMBDA_INIT = 0.2f;
constexpr int C_Q1 = 0, C_Q2 = 256, C_K1 = 512, C_K2 = 768, C_DV = 1024, C_SQ = 1536, C_SK = 2048, C_SV = 2560;

constexpr size_t MiB = 1u << 20;
constexpr size_t WS_CTL = 0, CTL_ZERO_BYTES = 1 * MiB;
constexpr size_t WS_TINFO = 1 * MiB;
constexpr size_t WS_LIST = 2 * MiB;
constexpr size_t WS_LGATE = 4 * MiB;
constexpr size_t WS_WIN = 6 * MiB;
constexpr size_t WS_WOUT = 12 * MiB;
constexpr size_t WS_WPG = 14 * MiB;
constexpr size_t WS_WPP = 16 * MiB;
constexpr size_t WS_XN = 20 * MiB;
constexpr size_t WS_O = 52 * MiB;
constexpr size_t WS_PROJ = 84 * MiB;
constexpr size_t WS_H1 = 180 * MiB;
constexpr size_t WS_PERAW = 244 * MiB;
constexpr size_t WS_PE16 = 308 * MiB;
constexpr size_t WS_P16 = 340 * MiB;
constexpr size_t WS_WGU = 352 * MiB;
constexpr size_t WS_WDN = 480 * MiB;
constexpr size_t WS_ACT = 544 * MiB;
constexpr size_t WS_Y = 688 * MiB;
constexpr size_t WS_END = 832 * MiB;
constexpr int CW_ATTQ = 64;
constexpr int CW_GCNT = 1024;
constexpr int CW_BAR = 4096;

constexpr int RING_BYTES = 131072;
constexpr int MISC_OFF = RING_BYTES;
constexpr int TAB_OFF = RING_BYTES + 256;
constexpr int LDS_BYTES = 147456;

constexpr int NWAVES = 8;
constexpr int N_PHASES = 10;

#define RLX_AGENT __ATOMIC_RELAXED, __HIP_MEMORY_SCOPE_AGENT
#define LDS_WAIT() asm volatile("s_waitcnt lgkmcnt(0)" ::: "memory")
#define VM_WAIT() asm volatile("s_waitcnt vmcnt(0)" ::: "memory")
__device__ __forceinline__ unsigned f2bf(float f) { unsigned u = __builtin_bit_cast(unsigned, f); return (u + 0x7fffu + ((u >> 16) & 1u)) >> 16; }
__device__ __forceinline__ unsigned pk2(float lo, float hi) { return f2bf(lo) | (f2bf(hi) << 16); }
__device__ __forceinline__ unsigned cvt_pk_bf16(float lo, float hi) { unsigned r; asm volatile("v_cvt_pk_bf16_f32 %0, %1, %2" : "=v"(r) : "v"(lo), "v"(hi)); return r; }
__device__ __forceinline__ float bf_lo(unsigned w) { return __builtin_bit_cast(float, w << 16); }
__device__ __forceinline__ float bf_hi(unsigned w) { return __builtin_bit_cast(float, w & 0xffff0000u); }
__device__ __forceinline__ float wave_sum(float v) {
#pragma unroll
    for (int o = 1; o < 64; o <<= 1) v += __shfl_xor(v, o);
    return v;
}
__device__ __forceinline__ float fast_sigmoid(float a) { return __builtin_amdgcn_rcpf(1.0f + __builtin_amdgcn_exp2f(-a * LOG2E)); }

namespace pg8 {
constexpr int BM = 256, BK = 64, HALF = 128, HTB = HALF * BK * 2, STAGE_BYTES = 8 * HTB, NXCD = 8, WGM = 8;
__host__ __device__ __forceinline__ int lds_byte(int r, int c) { const int st = (r >> 4) * 2 + (c >> 5), rr = r & 15, cc = c & 31, ob = rr * 64 + cc * 2; return st * 1024 + (ob ^ (((ob >> 9) & 1) << 5)); }
__host__ __device__ __forceinline__ void stage_rc(int b, int& R, int& C) { const int st = b / 1024, sb = b % 1024, swz = sb ^ (((sb >> 9) & 1) << 5); R = (st >> 1) * 16 + swz / 64; C = (st & 1) * 32 + (swz % 64) / 2; }
__host__ __device__ __forceinline__ int perm32(int rho) { const int n = rho >> 4, i = rho & 15; return 8 * (i >> 2) + 4 * n + (i & 3); }

struct Unit { int pm, pn, e, T; };

struct DenseOrder {
    const bf16* A; const bf16* Bt; int K, nM, nN, nwg, G, c;
    __device__ __forceinline__ void init(const bf16* A_, const bf16* Bt_, int M_, int N_, int K_, int G_, int c_) { A = A_; Bt = Bt_; K = K_; nM = M_ / BM; nN = N_ / BM; nwg = nM * nN; G = G_; c = c_; }
    __device__ __forceinline__ bool next(int i, Unit& u) const {
        const long L = (long)i * G + c; if (L >= nwg) return false;
        int wgid = (int)L; { const int q = nwg / NXCD, r = nwg % NXCD, xcd = wgid % NXCD, off = wgid / NXCD; wgid = (xcd < r ? xcd * (q + 1) : r * (q + 1) + (xcd - r) * q) + off; }
        const int nig = WGM * nN, gid = wgid / nig, fm = gid * WGM, gsz = (nM - fm) < WGM ? (nM - fm) : WGM;
        u.pm = fm + ((wgid % nig) % gsz); u.pn = (wgid % nig) / gsz; u.e = 0; u.T = u.pm; return true;
    }
    __device__ __forceinline__ const char* a_base() const { return (const char*)A; }
    __device__ __forceinline__ unsigned a_row(const Unit& u, int r) const { return (unsigned)(u.T * BM + r); }
    __device__ __forceinline__ const char* b_ptr(const Unit& u) const { return (const char*)Bt + (size_t)u.pn * BM * K * 2; }
};

template <bool GATHER, int NN  , int TPX  >
struct GroupedOrder {
    const bf16* A; const bf16* Bt; size_t b_estride; const int* list; const LAS int* tp; const LAS int* cnt; int K, G, c;
    __device__ __forceinline__ bool next(int i, Unit& u) const {
        const int tiles = tp[NEXP];
        const int L = i * G + c, round = L >> 8, w = L & 255, x = w & 7, j = w >> 3;
        const int T = round * (8 * TPX) + x * TPX + j / NN; if (T >= tiles) return false;
        int e = 0;
#pragma unroll 1
        for (int k = 16; k >= 1; k >>= 1) { if (tp[e + k] <= T) e += k; }
        u.e = __builtin_amdgcn_readfirstlane(e); u.T = __builtin_amdgcn_readfirstlane(T); u.pm = u.T - __builtin_amdgcn_readfirstlane(tp[u.e]); u.pn = j % NN; return true;
    }
    __device__ __forceinline__ const char* a_base() const { return (const char*)A; }
    __device__ __forceinline__ unsigned a_row(const Unit& u, int r) const {
        if constexpr (GATHER) { const int idx = u.pm * BM + r; return (idx < cnt[u.e]) ? (unsigned)list[u.e * LCAP + idx] : 0u; }
        else return (unsigned)(u.T * BM + r);
    }
    __device__ __forceinline__ const char* b_ptr(const Unit& u) const { return (const char*)Bt + (size_t)u.e * b_estride + (size_t)u.pn * BM * K * 2; }
};

template <class Epi, class Sched, bool ALIGN_EPI>
__device__ __forceinline__ void gemm_phase(LAS unsigned char* lds, const Sched& S, const Epi& E) {
    const int tid = threadIdx.x, wid = __builtin_amdgcn_readfirstlane(tid >> 6), lane = tid & 63, wr = wid >> 2, wc = wid & 3, fr = lane & 15, fq = lane >> 4;
    const int K = S.K, nt = K / BK;
    int RA[2], CA[2]; unsigned voffB[2];
#pragma unroll
    for (int i = 0; i < 2; ++i) { int R, C; stage_rc(tid * 16 + i * 8192, R, C); const int Rb = Epi::PERM ? ((R & ~31) + perm32(R & 31)) : R;
        RA[i] = R; CA[i] = C; voffB[i] = (unsigned)(Rb * K + C) * 2u; }
    const size_t kstep = (size_t)(BK * 2);
    const size_t hstep = (size_t)HALF * K * 2;
    const unsigned ldsw = (unsigned)wid * 1024u;
    const int aoff = lds_byte(wr * 64 + fr, fq * 8), boff = lds_byte(wc * 32 + fr, fq * 8);
#define PG8_SA(b, h) (((b) * 2 + (h)) * HTB)
#define PG8_SB(b, h) ((4 + (b) * 2 + (h)) * HTB)
#define PG8_STAGE(bufoff, gbase, voff) do { _Pragma("unroll") for (int _i = 0; _i < 2; ++_i) \
        __builtin_amdgcn_global_load_lds((const unsigned*)((const char*)(gbase) + (voff)[_i]), (LAS unsigned*)(lds + (bufoff) + ldsw + _i * 8192), 16, 0, 0); } while (0)
#define PG8_LDA(dst, b, h) do { _Pragma("unroll") for (int m = 0; m < 4; ++m) _Pragma("unroll") for (int k = 0; k < 2; ++k) dst[m][k] = *(const LAS bf16x8*)(lds + PG8_SA(b, h) + aoff + m * 2048 + k * 1024); } while (0)
#define PG8_LDB(dst, b, h) do { _Pragma("unroll") for (int n = 0; n < 2; ++n) _Pragma("unroll") for (int k = 0; k < 2; ++k) dst[n][k] = *(const LAS bf16x8*)(lds + PG8_SB(b, h) + boff + n * 2048 + k * 1024); } while (0)
#define PG8_MMA(ai, bj, At, Bt) do { __builtin_amdgcn_s_setprio(1); _Pragma("unroll") for (int m = 0; m < 4; ++m) _Pragma("unroll") for (int n = 0; n < 2; ++n) _Pragma("unroll") for (int k = 0; k < 2; ++k) \
        acc[ai][bj][m][n] = __builtin_amdgcn_mfma_f32_16x16x32_bf16(Bt[n][k], At[m][k], acc[ai][bj][m][n], 0, 0, 0); __builtin_amdgcn_s_setprio(0); } while (0)
#define PG8_WAIT_V(n) asm volatile("s_waitcnt vmcnt(" #n ")" ::: "memory")
#define PG8_WAIT_L(n) asm volatile("s_waitcnt lgkmcnt(" #n ")" ::: "memory")
#define PG8_BAR __builtin_amdgcn_s_barrier()
#define PG8_SCHED __builtin_amdgcn_sched_barrier(0)
    Unit cur, nxt, nx2; int ui = 0;
    if (!S.next(0, cur)) return;
    bool has_next = S.next(1, nxt);
    unsigned vcur[2][2], vnxt[2][2];
#pragma unroll
    for (int h = 0; h < 2; ++h)
#pragma unroll
        for (int i = 0; i < 2; ++i) vcur[h][i] = (S.a_row(cur, h * HALF + RA[i]) * (unsigned)K + (unsigned)CA[i]) * 2u;
#pragma unroll
    for (int h = 0; h < 2; ++h)
#pragma unroll
        for (int i = 0; i < 2; ++i) vnxt[h][i] = has_next ? (S.a_row(nxt, h * HALF + RA[i]) * (unsigned)K + (unsigned)CA[i]) * 2u : vcur[h][i];
    f32x4 acc[2][2][4][2];
#pragma unroll
    for (int a = 0; a < 2; ++a)
#pragma unroll
        for (int b = 0; b < 2; ++b)
#pragma unroll
            for (int m = 0; m < 4; ++m)
#pragma unroll
                for (int n = 0; n < 2; ++n) acc[a][b][m][n] = (f32x4){0.f, 0.f, 0.f, 0.f};
    bf16x8 At[4][2], B0[2][2], B1[2][2];
    const char* const abase = S.a_base();
    const char* cB = S.b_ptr(cur);
    PG8_STAGE(PG8_SB(0, 0), cB, voffB); PG8_STAGE(PG8_SB(0, 1), cB + hstep, voffB); PG8_STAGE(PG8_SA(0, 0), abase, vcur[0]); PG8_STAGE(PG8_SA(0, 1), abase, vcur[1]);
    if (wr == 1) PG8_BAR;
    PG8_WAIT_V(2); PG8_BAR;
    PG8_STAGE(PG8_SB(1, 0), cB + kstep, voffB); PG8_STAGE(PG8_SA(1, 0), abase + kstep, vcur[0]); PG8_STAGE(PG8_SB(1, 1), cB + hstep + kstep, voffB);
    PG8_WAIT_V(6); PG8_BAR;
    for (;;) {
        const char* nB = has_next ? S.b_ptr(nxt) : cB;
        for (int t = 0; t < nt; t += 2) {
            const bool last = (t == nt - 2);
            const char* a1 = abase + (size_t)(t + 1) * kstep;
            const char* a2 = last ? abase : abase + (size_t)(t + 2) * kstep; const char* b2 = last ? nB : cB + (size_t)(t + 2) * kstep;
            const char* a3 = a2 + kstep; const char* b3 = b2 + kstep;
            unsigned v2[2][2];
#pragma unroll
            for (int h = 0; h < 2; ++h)
#pragma unroll
                for (int i = 0; i < 2; ++i) v2[h][i] = (last && has_next) ? vnxt[h][i] : vcur[h][i];
            PG8_LDB(B0, 0, 0); PG8_LDB(B1, 0, 1); PG8_SCHED; PG8_LDA(At, 0, 0); PG8_STAGE(PG8_SA(1, 1), a1, vcur[1]);
            PG8_WAIT_V(8); PG8_WAIT_L(0); PG8_BAR; PG8_MMA(0, 0, At, B0); PG8_MMA(0, 1, At, B1); PG8_BAR; PG8_SCHED;
            PG8_LDA(At, 0, 1); PG8_STAGE(PG8_SB(0, 0), b2, voffB); PG8_STAGE(PG8_SB(0, 1), b2 + hstep, voffB); PG8_STAGE(PG8_SA(0, 0), a2, v2[0]);
            PG8_WAIT_V(8); PG8_WAIT_L(0); PG8_BAR; PG8_MMA(1, 0, At, B0); PG8_MMA(1, 1, At, B1); PG8_BAR; PG8_SCHED;
            PG8_LDB(B0, 1, 0); PG8_LDB(B1, 1, 1); PG8_SCHED; PG8_LDA(At, 1, 0); PG8_STAGE(PG8_SA(0, 1), a2, v2[1]);
            PG8_WAIT_V(8); PG8_WAIT_L(0); PG8_BAR; PG8_MMA(0, 0, At, B0); PG8_MMA(0, 1, At, B1); PG8_BAR; PG8_SCHED;
            PG8_LDA(At, 1, 1); PG8_STAGE(PG8_SB(1, 0), b3, voffB); PG8_STAGE(PG8_SB(1, 1), b3 + hstep, voffB); PG8_STAGE(PG8_SA(1, 0), a3, v2[0]);
            PG8_WAIT_V(8); PG8_WAIT_L(0); PG8_BAR; PG8_MMA(1, 0, At, B0); PG8_MMA(1, 1, At, B1); PG8_BAR; PG8_SCHED;
        }
        if constexpr (ALIGN_EPI) { if (wr == 0) PG8_BAR; }
        const bool has_nx2 = has_next && S.next(ui + 2, nx2);
        unsigned raw[2][2];
#pragma unroll
        for (int h = 0; h < 2; ++h)
#pragma unroll
            for (int i = 0; i < 2; ++i) raw[h][i] = has_nx2 ? S.a_row(nx2, h * HALF + RA[i]) : 0u;
        E(acc, cur, wr, wc, fr, fq);
        if (!has_next) break;
#pragma unroll
        for (int a = 0; a < 2; ++a)
#pragma unroll
            for (int b = 0; b < 2; ++b)
#pragma unroll
                for (int m = 0; m < 4; ++m)
#pragma unroll
                    for (int n = 0; n < 2; ++n) acc[a][b][m][n] = (f32x4){0.f, 0.f, 0.f, 0.f};
#pragma unroll
        for (int h = 0; h < 2; ++h)
#pragma unroll
            for (int i = 0; i < 2; ++i) { vcur[h][i] = vnxt[h][i]; if (has_nx2) vnxt[h][i] = (raw[h][i] * (unsigned)K + (unsigned)CA[i]) * 2u; }
        cur = nxt; cB = nB; nxt = nx2; has_next = has_nx2; ++ui;
        if constexpr (ALIGN_EPI) { if (wr == 1) PG8_BAR; }
    }
    PG8_WAIT_V(0);
    if constexpr (!ALIGN_EPI) { if (wr == 0) PG8_BAR; }
    PG8_BAR;
#undef PG8_SA
#undef PG8_SB
#undef PG8_STAGE
#undef PG8_LDA
#undef PG8_LDB
#undef PG8_MMA
#undef PG8_WAIT_V
#undef PG8_WAIT_L
#undef PG8_BAR
#undef PG8_SCHED
}

struct EpiProj {
    static constexpr bool PERM = true;
    bf16* O;
    __device__ __forceinline__ void operator()(const f32x4 (&acc)[2][2][4][2], const Unit& u, int wr, int wc, int fr, int fq) const {
        const int row0 = u.T * BM + wr * 64 + fr, colt = u.pn * BM;
        const float sc = (colt < 512 || (colt >= 1536 && colt < 2048)) ? C2 : 1.0f;
        const int col0 = colt + wc * 32 + 8 * fq;
#pragma unroll
        for (int ai = 0; ai < 2; ++ai)
#pragma unroll
            for (int m = 0; m < 4; ++m) { bf16* rowp = O + (size_t)(row0 + ai * HALF + m * 16) * NIN + col0;
#pragma unroll
                for (int bj = 0; bj < 2; ++bj) { const f32x4 v0 = acc[ai][bj][m][0] * sc, v1 = acc[ai][bj][m][1] * sc;
                    u32x4 w; w.x = cvt_pk_bf16(v0[0], v0[1]); w.y = cvt_pk_bf16(v0[2], v0[3]); w.z = cvt_pk_bf16(v1[0], v1[1]); w.w = cvt_pk_bf16(v1[2], v1[3]);
                    *(u32x4*)(rowp + bj * HALF) = w; } }
    }
};
struct EpiResF32 {
    static constexpr bool PERM = false;
    const float* base; float* out;
    __device__ __forceinline__ void operator()(const f32x4 (&acc)[2][2][4][2], const Unit& u, int wr, int wc, int fr, int fq) const {
        const int col0 = u.pn * BM + wc * 32 + 4 * fq;
#pragma unroll
        for (int ai = 0; ai < 2; ++ai)
#pragma unroll
            for (int m = 0; m < 4; ++m) { const size_t off = (size_t)(u.T * BM + ai * HALF + wr * 64 + m * 16 + fr) * DM + col0;
#pragma unroll
                for (int bj = 0; bj < 2; ++bj)
#pragma unroll
                    for (int n = 0; n < 2; ++n) { f32x4 o = acc[ai][bj][m][n]; if (base) o += *(const f32x4*)(base + off + bj * HALF + n * 16); *(f32x4*)(out + off + bj * HALF + n * 16) = o; }
                if (m & 1) asm volatile("" ::: "memory"); }
    }
};
struct EpiGlu {
    static constexpr bool PERM = true;
    bf16* ACT; const float* bgu;
    __device__ __forceinline__ void operator()(const f32x4 (&acc)[2][2][4][2], const Unit& u, int wr, int wc, int fr, int fq) const {
        const int j0 = u.pn * HALF + wc * 32 + 8 * fq;
        const float* bp = bgu + (size_t)u.e * 2048 + 2 * j0;
        const f32x4 b0 = *(const f32x4*)(bp), b1 = *(const f32x4*)(bp + 4), b2 = *(const f32x4*)(bp + 8), b3 = *(const f32x4*)(bp + 12);
        const float bg[8] = {b0[0], b0[2], b1[0], b1[2], b2[0], b2[2], b3[0], b3[2]};
        const float bl[8] = {b0[1], b0[3], b1[1], b1[3], b2[1], b2[3], b3[1], b3[3]};
#pragma unroll
        for (int ai = 0; ai < 2; ++ai)
#pragma unroll
            for (int m = 0; m < 4; ++m) {
                const size_t row = (size_t)(u.T * BM + ai * HALF + wr * 64 + m * 16 + fr);
                float a[8];
#pragma unroll
                for (int i = 0; i < 8; ++i) {
                    const float g = fminf(acc[ai][0][m][i >> 2][i & 3] + bg[i], 7.0f);
                    const float l = fminf(fmaxf(acc[ai][1][m][i >> 2][i & 3] + bl[i], -7.0f), 7.0f);
                    a[i] = g * fast_sigmoid(1.702f * g) * (l + 1.0f);
                }
                u32x4 w; w.x = cvt_pk_bf16(a[0], a[1]); w.y = cvt_pk_bf16(a[2], a[3]); w.z = cvt_pk_bf16(a[4], a[5]); w.w = cvt_pk_bf16(a[6], a[7]);
                *(u32x4*)(ACT + row * DM + j0) = w;
            }
    }
};
struct EpiDown {
    static constexpr bool PERM = true;
    bf16* Y; const float* bdn; const float* lgate;
    __device__ __forceinline__ void operator()(const f32x4 (&acc)[2][2][4][2], const Unit& u, int wr, int wc, int fr, int fq) const {
        const int col0 = u.pn * BM + wc * 32 + 8 * fq;
        f32x4 bv[2][2];
#pragma unroll
        for (int bj = 0; bj < 2; ++bj)
#pragma unroll
            for (int n = 0; n < 2; ++n) bv[bj][n] = *(const f32x4*)(bdn + (size_t)u.e * DM + col0 + bj * HALF + 4 * n);
#pragma unroll
        for (int ai = 0; ai < 2; ++ai)
#pragma unroll
            for (int m = 0; m < 4; ++m) {
                const int rl = ai * HALF + wr * 64 + m * 16 + fr;
                const float g = lgate[(size_t)u.e * LCAP + u.pm * BM + rl];
                bf16* rowp = Y + (size_t)(u.T * BM + rl) * DM + col0;
#pragma unroll
                for (int bj = 0; bj < 2; ++bj) { const f32x4 v0 = (acc[ai][bj][m][0] + bv[bj][0]) * g, v1 = (acc[ai][bj][m][1] + bv[bj][1]) * g;
                    u32x4 w; w.x = cvt_pk_bf16(v0[0], v0[1]); w.y = cvt_pk_bf16(v0[2], v0[3]); w.z = cvt_pk_bf16(v1[0], v1[1]); w.w = cvt_pk_bf16(v1[2], v1[3]);
                    *(u32x4*)(rowp + bj * HALF) = w; } }
    }
};
struct EpiPle {
    static constexpr bool PERM = false;
    const float* h2; const bf16* pe; float* out;
    __device__ __forceinline__ void operator()(const f32x4 (&acc)[2][2][4][2], const Unit& u, int wr, int wc, int fr, int fq) const {
        const int col0 = u.pn * BM + wc * 32 + 4 * fq;
#pragma unroll
        for (int ai = 0; ai < 2; ++ai)
#pragma unroll
            for (int m = 0; m < 4; ++m) { const size_t off = (size_t)(u.T * BM + ai * HALF + wr * 64 + m * 16 + fr) * DM + col0;
#pragma unroll
                for (int bj = 0; bj < 2; ++bj)
#pragma unroll
                    for (int n = 0; n < 2; ++n) { const size_t o2 = off + bj * HALF + n * 16; const f32x4 hv = *(const f32x4*)(h2 + o2); const u32x2 pw = *(const u32x2*)(pe + o2); const f32x4 a = acc[ai][bj][m][n];
                        f32x4 o; o[0] = hv[0] + fast_sigmoid(a[0]) * bf_lo(pw.x); o[1] = hv[1] + fast_sigmoid(a[1]) * bf_hi(pw.x); o[2] = hv[2] + fast_sigmoid(a[2]) * bf_lo(pw.y); o[3] = hv[3] + fast_sigmoid(a[3]) * bf_hi(pw.y);
                        *(f32x4*)(out + o2) = o; }
                if (m & 1) asm volatile("" ::: "memory"); }
    }
};
}

namespace att {
constexpr int PITCH = NIN;
constexpr int STAGE = 24576;
constexpr int LDS_TBL = 2 * STAGE;
#define ATT_SBAR() __builtin_amdgcn_sched_barrier(0)
#define ATT_WAIT_BAR() asm volatile("s_waitcnt vmcnt(0) lgkmcnt(0)\n\ts_barrier" ::: "memory")
__device__ __forceinline__ int crow(int r, int hi) { return (r & 3) + 8 * (r >> 2) + 4 * hi; }
__device__ __forceinline__ void glds16(const void* gsrc, unsigned lds_dst) { unsigned keep;
    asm volatile("s_mov_b32 %0, m0\n\ts_mov_b32 m0, %2\n\ts_nop 0\n\tglobal_load_lds_dwordx4 %1, off\n\ts_mov_b32 m0, %0" : "=&s"(keep) : "v"(gsrc), "s"(lds_dst) : "memory"); }
__device__ __forceinline__ s16x4 vtr(const LAS unsigned char* p) { return __builtin_bit_cast(s16x4, __builtin_amdgcn_ds_read_tr16_b64_v4i16((LAS v4i16_t*)p)); }
__device__ __forceinline__ float partner_combine_max(float m) { auto rr = __builtin_amdgcn_permlane32_swap(__float_as_uint(m), __float_as_uint(m), false, false); return fmaxf(__uint_as_float(rr[0]), __uint_as_float(rr[1])); }
__device__ __forceinline__ float partner_combine_sum(float m) { auto rr = __builtin_amdgcn_permlane32_swap(__float_as_uint(m), __float_as_uint(m), false, false); return __uint_as_float(rr[0]) + __uint_as_float(rr[1]); }
__device__ __forceinline__ bf16x8 pack8(const f32x16& p, int b) {
    u32x4 w; w.x = cvt_pk_bf16(p[b], p[b + 1]); w.y = cvt_pk_bf16(p[b + 2], p[b + 3]); w.z = cvt_pk_bf16(p[b + 4], p[b + 5]); w.w = cvt_pk_bf16(p[b + 6], p[b + 7]);
    return __builtin_bit_cast(bf16x8, w);
}
__device__ __forceinline__ void dma_k(const bf16* Ktile, unsigned kdst, int wid, int lane) {
    glds16(Ktile + (size_t)lane * PITCH + wid * 8, (unsigned)__builtin_amdgcn_readfirstlane(kdst + wid * 1024));
}
template <int NVT> __device__ __forceinline__ void dma_v(const bf16* Vtile, unsigned vdst, int wid, int lane) {
#pragma unroll
    for (int q = 0; q < NVT / 2; ++q) { const int p = wid + 8 * q;
        glds16(Vtile + (size_t)(16 * (p & 3) + (lane >> 2)) * PITCH + (p >> 2) * 32 + (lane & 3) * 8, (unsigned)__builtin_amdgcn_readfirstlane(vdst + p * 1024)); }
}
__device__ __forceinline__ void qkt(f32x16& p0, f32x16& p1, const LAS unsigned char* kp, const bf16x8* qf) {
    p0 = f32x16{}; p1 = f32x16{};
#pragma unroll
    for (int d0 = 0; d0 < 4; ++d0) {
        const bf16x8 k0 = *(const LAS bf16x8*)(kp + d0 * 2048), k1 = *(const LAS bf16x8*)(kp + d0 * 2048 + 512);
        p0 = __builtin_amdgcn_mfma_f32_32x32x16_bf16(k0, qf[d0], p0, 0, 0, 0);
        p1 = __builtin_amdgcn_mfma_f32_32x32x16_bf16(k1, qf[d0], p1, 0, 0, 0);
    }
}
template <int NVT> __device__ __forceinline__ void pv(f32x16* o, const LAS unsigned char* vp, const f32x16& p0, const f32x16& p1) {
    const bf16x8 pf0 = pack8(p0, 0), pf1 = pack8(p0, 8), pf2 = pack8(p1, 0), pf3 = pack8(p1, 8);
#pragma unroll
    for (int nt = 0; nt < NVT; ++nt) {
#pragma unroll
        for (int s = 0; s < 4; ++s) {
            const s16x4 lo = vtr(vp + nt * 4096 + s * 1024), hi = vtr(vp + nt * 4096 + s * 1024 + 512);
            const bf16x8 vf = (bf16x8){lo[0], lo[1], lo[2], lo[3], hi[0], hi[1], hi[2], hi[3]};
            o[nt] = __builtin_amdgcn_mfma_f32_32x32x16_bf16(vf, s == 0 ? pf0 : s == 1 ? pf1 : s == 2 ? pf2 : pf3, o[nt], 0, 0, 0);
        }
    }
}

__device__ __forceinline__ float diff_map(f32x16* o, const bf16* Qw, const bf16* Kh, const bf16* Vh, int q0, int wid, int lane, LAS unsigned char* shm, const LAS float* tbl, float c31) {
    const int r32 = lane & 31, hi = lane >> 5;
    const unsigned lds0 = (unsigned)(uintptr_t)shm;
    bf16x8 qf[4];
#pragma unroll
    for (int d0 = 0; d0 < 4; ++d0) qf[d0] = *(const bf16x8*)(Qw + (size_t)r32 * PITCH + d0 * 16 + hi * 8);
#pragma unroll
    for (int d0 = 0; d0 < 4; ++d0) asm volatile("" : "+v"(qf[d0]));
#pragma unroll
    for (int nt = 0; nt < 4; ++nt) o[nt] = f32x16{};
    float mrun = -INFINITY, l = 0.f;
    const int NT = (q0 + 256) / 64;
    const int qlo = q0 + wid * 32, qrow = qlo + r32;
    const LAS unsigned char* kp0 = shm + hi * 1024 + r32 * 16;
    const LAS unsigned char* vp0 = shm + 8192 + ((lane >> 4) & 1) * 32 + (lane & 3) * 8 + (4 * hi + ((lane & 15) >> 2)) * 64;
    dma_k(Kh, lds0, wid, lane); dma_v<4>(Vh, lds0 + 8192, wid, lane);
    for (int t = 0; t < NT; ++t) {
        ATT_WAIT_BAR();
        const int st = (t & 1) * STAGE;
        if (t + 1 < NT) { const int sn = ((t + 1) & 1) * STAGE; dma_k(Kh + (size_t)(t + 1) * 64 * PITCH, lds0 + sn, wid, lane); dma_v<4>(Vh + (size_t)(t + 1) * 64 * PITCH, lds0 + sn + 8192, wid, lane); }
        const int k0 = t * 64;
        if (k0 > qlo + 31) continue;
        f32x16 p0, p1;
        qkt(p0, p1, kp0 + st, qf);
        if (qlo - (k0 + 63) >= 113) {
#pragma unroll
            for (int r = 0; r < 16; ++r) { p0[r] += c31; p1[r] += c31; }
        } else {
            int relb = qrow - k0 - 4 * hi; asm volatile("" : "+v"(relb));
#pragma unroll
            for (int r = 0; r < 16; ++r) {
                const int rel0 = relb - ((r & 3) + 8 * (r >> 2)), rel1 = rel0 - 32;
                const float b0 = tbl[rel0 < 0 ? 0 : (rel0 > 127 ? 127 : rel0)], b1 = tbl[rel1 < 0 ? 0 : (rel1 > 127 ? 127 : rel1)];
                p0[r] = rel0 < 0 ? -INFINITY : p0[r] + b0; p1[r] = rel1 < 0 ? -INFINITY : p1[r] + b1;
            }
        }
        float rm = fmaxf(p0[0], p1[0]);
#pragma unroll
        for (int r = 1; r < 16; ++r) rm = fmaxf(rm, fmaxf(p0[r], p1[r]));
        rm = partner_combine_max(rm);
        const float mn = fmaxf(mrun, rm);
        const float alpha = __builtin_amdgcn_exp2f(mrun - mn);
        mrun = mn; l *= alpha;
#pragma unroll
        for (int nt = 0; nt < 4; ++nt)
#pragma unroll
            for (int r = 0; r < 16; ++r) o[nt][r] *= alpha;
        float s = 0.f;
#pragma unroll
        for (int r = 0; r < 16; ++r) { p0[r] = __builtin_amdgcn_exp2f(p0[r] - mn); p1[r] = __builtin_amdgcn_exp2f(p1[r] - mn); s += p0[r] + p1[r]; }
        l += s;
        pv<4>(o, vp0 + st, p0, p1);
    }
    ATT_WAIT_BAR();
    return partner_combine_sum(l);
}

__device__ __forceinline__ void diff_unit(int b, int h, int qb, const bf16* PROJ, bf16* O, const float* rel_bias, const float* subln, float lam, LAS unsigned char* shm) {
    const int tid = threadIdx.x, lane = tid & 63, r32 = lane & 31, hi = lane >> 5; const int wid = __builtin_amdgcn_readfirstlane(tid >> 6);
    LAS float* tbl = (LAS float*)(shm + LDS_TBL);
    if (tid < 128) { const int n = tid; int bk = n;
        if (n >= 16) { bk = 16 + (n >= 19) + (n >= 21) + (n >= 24) + (n >= 27) + (n >= 31) + (n >= 35) + (n >= 40) + (n >= 46) + (n >= 52) + (n >= 59) + (n >= 67) + (n >= 77) + (n >= 87) + (n >= 99) + (n >= 113); }
        tbl[n] = rel_bias[bk * 4 + h] * LOG2E; }
    const float c31 = rel_bias[31 * 4 + h] * LOG2E;
    const int q0 = qb * 256; const size_t rowbase = (size_t)b * SEQ;
    const bf16* P0 = PROJ + rowbase * PITCH;
    const bf16* Qw1 = P0 + (size_t)(q0 + wid * 32) * PITCH + C_Q1 + h * 64;
    f32x16 o2[4]; u32x2 o1p[4][4][1];
    {
        f32x16 o1[4];
        const float l1 = diff_map(o1, Qw1, P0 + C_K1 + h * 64, P0 + C_DV + h * 128, q0, wid, lane, shm, tbl, c31);
        const float i1 = 1.0f / l1;
#pragma unroll
        for (int nt = 0; nt < 4; ++nt)
#pragma unroll
            for (int c = 0; c < 4; ++c) { o1p[nt][c][0].x = cvt_pk_bf16(o1[nt][4 * c] * i1, o1[nt][4 * c + 1] * i1); o1p[nt][c][0].y = cvt_pk_bf16(o1[nt][4 * c + 2] * i1, o1[nt][4 * c + 3] * i1); }
    }
    const float l2 = diff_map(o2, Qw1 + (C_Q2 - C_Q1), P0 + C_K2 + h * 64, P0 + C_DV + h * 128, q0, wid, lane, shm, tbl, c31);
    const float i2 = lam / l2;
    float ss = 0.f;
#pragma unroll
    for (int nt = 0; nt < 4; ++nt)
#pragma unroll
        for (int c = 0; c < 4; ++c) {
            const float a0 = bf_lo(o1p[nt][c][0].x) - o2[nt][4 * c] * i2, a1 = bf_hi(o1p[nt][c][0].x) - o2[nt][4 * c + 1] * i2, a2 = bf_lo(o1p[nt][c][0].y) - o2[nt][4 * c + 2] * i2, a3 = bf_hi(o1p[nt][c][0].y) - o2[nt][4 * c + 3] * i2;
            o2[nt][4 * c] = a0; o2[nt][4 * c + 1] = a1; o2[nt][4 * c + 2] = a2; o2[nt][4 * c + 3] = a3; ss += (a0 * a0 + a1 * a1) + (a2 * a2 + a3 * a3); }
    ss = partner_combine_sum(ss);
    const float rs = (1.0f - LAMBDA_INIT) / sqrtf(ss * (1.0f / 128.0f) + NORM_EPS);
    bf16* Ow = O + (rowbase + q0 + wid * 32 + r32) * DM + h * 128;
#pragma unroll
    for (int nt = 0; nt < 4; ++nt)
#pragma unroll
        for (int c = 0; c < 4; ++c) { const int n0 = 32 * nt + 8 * c + 4 * hi; const f32x4 g = *(const f32x4*)(subln + n0);
            u32x2 w; w.x = cvt_pk_bf16(o2[nt][4 * c] * rs * g[0], o2[nt][4 * c + 1] * rs * g[1]); w.y = cvt_pk_bf16(o2[nt][4 * c + 2] * rs * g[2], o2[nt][4 * c + 3] * rs * g[3]);
            *(u32x2*)(Ow + n0) = w; }
}

template <bool BAND> __device__ __forceinline__ void sb_sub(f32x16& p, float& R, int krel  , int hi) {
    float f[16];
#pragma unroll
    for (int r = 0; r < 16; ++r) {
        const float z = fmaxf(p[r], -100.0f);
        const float u = __builtin_amdgcn_exp2f(-z);
        float bt = __builtin_amdgcn_rcpf(1.0f + u);
        float ff = u * bt;
        if (BAND) { const bool masked = (krel - ((r & 3) + 8 * (r >> 2))) <= 0; bt = masked ? 0.f : bt; ff = masked ? 1.f : ff; }
        p[r] = bt; f[r] = ff;
    }
    float GP[4], PS[4];
#pragma unroll
    for (int c = 0; c < 4; ++c) { const float g = (f[4 * c] * f[4 * c + 1]) * (f[4 * c + 2] * f[4 * c + 3]);
        auto rr = __builtin_amdgcn_permlane32_swap(__float_as_uint(g), __float_as_uint(g), false, false);
        const float a0 = __uint_as_float(rr[0]), a1 = __uint_as_float(rr[1]);
        GP[c] = a0 * a1; PS[c] = hi ? 1.0f : a1; }
    float T = R;
#pragma unroll
    for (int c = 3; c >= 0; --c) {
        const float base = T * PS[c];
        const float s3 = base, s2 = s3 * f[4 * c + 3], s1 = s2 * f[4 * c + 2], s0 = s1 * f[4 * c + 1];
        p[4 * c + 3] *= s3; p[4 * c + 2] *= s2; p[4 * c + 1] *= s1; p[4 * c] *= s0;
        T *= GP[c];
    }
    R = T;
}

__device__ __forceinline__ void sb_unit(int b, int h, int qb, const bf16* PROJ, bf16* O, LAS unsigned char* shm) {
    const int tid = threadIdx.x, lane = tid & 63, r32 = lane & 31, hi = lane >> 5; const int wid = __builtin_amdgcn_readfirstlane(tid >> 6);
    const unsigned lds0 = (unsigned)(uintptr_t)shm;
    const int q0 = qb * 256; const size_t rowbase = (size_t)b * SEQ;
    const bf16* P0 = PROJ + rowbase * PITCH;
    const bf16* Qw = P0 + (size_t)(q0 + wid * 32) * PITCH + C_SQ + h * 64;
    const bf16* Kh = P0 + C_SK + h * 64; const bf16* Vh = P0 + C_SV + h * 64;
    bf16x8 qf[4];
#pragma unroll
    for (int d0 = 0; d0 < 4; ++d0) qf[d0] = *(const bf16x8*)(Qw + (size_t)r32 * PITCH + d0 * 16 + hi * 8);
#pragma unroll
    for (int d0 = 0; d0 < 4; ++d0) asm volatile("" : "+v"(qf[d0]));
    f32x16 o[2]; o[0] = f32x16{}; o[1] = f32x16{};
    float R = 1.0f;
    const int NT = (q0 + 256) / 64;
    const int qlo = q0 + wid * 32, qrow = qlo + r32;
    const LAS unsigned char* kp0 = shm + hi * 1024 + r32 * 16;
    const LAS unsigned char* vp0 = shm + 8192 + ((lane >> 4) & 1) * 32 + (lane & 3) * 8 + (4 * hi + ((lane & 15) >> 2)) * 64;
    dma_k(Kh + (size_t)(NT - 1) * 64 * PITCH, lds0 + ((NT - 1) & 1) * STAGE, wid, lane); dma_v<2>(Vh + (size_t)(NT - 1) * 64 * PITCH, lds0 + ((NT - 1) & 1) * STAGE + 8192, wid, lane);
    for (int t = NT - 1; t >= 0; --t) {
        ATT_WAIT_BAR();
        const int st = (t & 1) * STAGE;
        if (t > 0) { const int sn = ((t - 1) & 1) * STAGE; dma_k(Kh + (size_t)(t - 1) * 64 * PITCH, lds0 + sn, wid, lane); dma_v<2>(Vh + (size_t)(t - 1) * 64 * PITCH, lds0 + sn + 8192, wid, lane); }
        const int k0 = t * 64;
        if (k0 >= qlo + 31) continue;
        f32x16 p0, p1;
        qkt(p0, p1, kp0 + st, qf);
        int krel = qrow - (k0 + 4 * hi); asm volatile("" : "+v"(krel));
        if (k0 + 63 >= qlo) { sb_sub<true>(p1, R, krel - 32, hi); sb_sub<true>(p0, R, krel, hi); }
        else { sb_sub<false>(p1, R, 0, hi); sb_sub<false>(p0, R, 0, hi); }
        pv<2>(o, vp0 + st, p0, p1);
    }
    ATT_WAIT_BAR();
    bf16* Ow = O + (rowbase + qrow) * DM + 512 + h * 64;
#pragma unroll
    for (int nt = 0; nt < 2; ++nt)
#pragma unroll
        for (int c = 0; c < 4; ++c) { const int n0 = 32 * nt + 8 * c + 4 * hi;
            u32x2 w; w.x = cvt_pk_bf16(o[nt][4 * c], o[nt][4 * c + 1]); w.y = cvt_pk_bf16(o[nt][4 * c + 2], o[nt][4 * c + 3]);
            *(u32x2*)(Ow + n0) = w; }
}
#undef ATT_SBAR
}

#define XB_TMO      128
#define XB_XCNT(j)  (256  + 64 * (j))
#define XB_XSUB(j)  (1280 + 64 * (j))
#define XB_XGEN(j)  (2304 + 64 * (j))
#define XB_TOP      3328
#define XB_TOPGEN   3392
#define XCD_BAR_WORDS 3456
#define XB_SPIN_CAP (1u << 18)
__device__ __forceinline__ unsigned xb_ld(unsigned* p)              { return __hip_atomic_load(p, __ATOMIC_RELAXED, __HIP_MEMORY_SCOPE_AGENT); }
__device__ __forceinline__ unsigned xb_add(unsigned* p, unsigned v) { return __hip_atomic_fetch_add(p, v, __ATOMIC_RELAXED, __HIP_MEMORY_SCOPE_AGENT); }
__device__ __forceinline__ unsigned xb_xcc_id() { return (unsigned)__builtin_amdgcn_s_getreg((3 << 11) | 20) & 0xFu; }
#define XB_SPIN(cond, bar) do { unsigned _sp = 0; while (cond) { __builtin_amdgcn_s_sleep(1); \
    if ((++_sp & 255u) == 0u) { if (xb_ld(&(bar)[XB_TMO])) break; if (_sp > XB_SPIN_CAP) { atomicAdd(&(bar)[XB_TMO], 1u); break; } } } } while (0)
struct XcdBarrier { unsigned* bar; unsigned x; volatile LAS unsigned* st; };
__device__ __forceinline__ XcdBarrier xcd_barrier_post(unsigned* bar, volatile LAS unsigned* st) {
    XcdBarrier b; b.bar = bar; b.x = xb_xcc_id(); b.st = st;
    if (threadIdx.x == 0) (void)xb_add(&bar[XB_XCNT(b.x)], 1u);
    return b;
}
__device__ __forceinline__ void xcd_barrier_complete(unsigned* bar, unsigned x, unsigned& nloc, unsigned& nx) {
    const unsigned G = gridDim.x * gridDim.y * gridDim.z;
    unsigned sum, cnt, mine, sp = 0u;
    for (;;) {
        sum = 0u; cnt = 0u; mine = 0u;
#pragma unroll
        for (unsigned j = 0; j < 16; ++j) { const unsigned c = xb_ld(&bar[XB_XCNT(j)]); sum += c; cnt += (c > 0u) ? 1u : 0u; mine = (j == x) ? c : mine; }
        if (sum == G) break;
        __builtin_amdgcn_s_sleep(1);
        if ((++sp & 255u) == 0u) { if (xb_ld(&bar[XB_TMO])) break; if (sp > XB_SPIN_CAP) { atomicAdd(&bar[XB_TMO], 1u); break; } }
    }
    nloc = mine > 0u ? mine : 1u; nx = cnt > 0u ? cnt : 1u;
}
__device__ __forceinline__ void xcd_barrier(const XcdBarrier& b) {
    asm volatile("s_waitcnt vmcnt(0)" ::: "memory");
    __syncthreads();
    if (threadIdx.x == 0) {
        unsigned* bar = b.bar;
        __builtin_amdgcn_s_waitcnt(0);
        unsigned nloc = b.st[0], nx = b.st[1];
        if (nloc == 0u) { xcd_barrier_complete(bar, b.x, nloc, nx); b.st[0] = nloc; b.st[1] = nx; }
        const unsigned old = xb_add(&bar[XB_XSUB(b.x)], 1u);
        const unsigned gen = old / nloc;
        if (old + 1u == (gen + 1u) * nloc) {
            __builtin_amdgcn_fence(__ATOMIC_RELEASE, "agent");
            asm volatile("s_waitcnt vmcnt(0)" ::: "memory");
            const unsigned og = xb_add(&bar[XB_TOP], 1u);
            const unsigned tg = og / nx;
            if (og + 1u == (tg + 1u) * nx) xb_add(&bar[XB_TOPGEN], 1u);
            else XB_SPIN(xb_ld(&bar[XB_TOPGEN]) == tg, bar);
            __builtin_amdgcn_fence(__ATOMIC_ACQUIRE, "agent");
            xb_add(&bar[XB_XGEN(b.x)], 1u);
            asm volatile("s_waitcnt vmcnt(0)" ::: "memory");
        } else {
            XB_SPIN(xb_ld(&bar[XB_XGEN(b.x)]) == gen, bar);
            __builtin_amdgcn_fence(__ATOMIC_ACQUIRE, "agent");
            asm volatile("s_waitcnt vmcnt(0)" ::: "memory");
        }
    }
    __syncthreads();
}

struct Args {
    const float *x, *p, *w_in, *w_out, *attn_norm, *moe_norm, *rel_bias, *lq1, *lk1, *lq2, *lk2, *subln, *router_w, *router_b, *w_gu, *b_gu, *w_dn, *b_dn, *ple_proj, *ple_norm, *ple_gate, *final_norm;
    float* out; unsigned char* ws; int ph_lo, ph_hi;
};

template <bool GLU> __device__ __forceinline__ void p0_transpose_item(const float* W, int K, int N, bf16* WT, LAS float* scr, int item, int lane) {
    const int nblk = N / 32, kb = item / nblk, nb = item % nblk, k0 = 64 * kb, n0 = 32 * nb;
#pragma unroll 8
    for (int i = 0; i < 32; ++i) { const int kk = 2 * i + (lane >> 5); scr[kk * 33 + (lane & 31)] = W[(size_t)(k0 + kk) * N + n0 + (lane & 31)]; }
    LDS_WAIT(); asm volatile("" ::: "memory");
    const int c = lane & 7;
#pragma unroll
    for (int j = 0; j < 4; ++j) { const int n = (lane >> 3) + 8 * j; const LAS float* s = scr + (8 * c) * 33 + n;
        v4u o; o.x = pk2(s[0 * 33], s[1 * 33]); o.y = pk2(s[2 * 33], s[3 * 33]); o.z = pk2(s[4 * 33], s[5 * 33]); o.w = pk2(s[6 * 33], s[7 * 33]);
        int nn = n0 + n; if (GLU) { const int jj = nn >> 1; nn = 256 * (jj >> 7) + 128 * (nn & 1) + (jj & 127); }
        *(GAS v4u*)(WT + (size_t)nn * K + k0 + 8 * c) = o; }
    LDS_WAIT(); asm volatile("" ::: "memory");
}
template <bool GLU> __device__ __forceinline__ void conv_items(const float* W, int K, int N, bf16* WT, LAS float* scr, int item0, int nitems, int lane) {
    const int nblk = N / 32, lr = lane >> 3, lc = 4 * (lane & 7), c = lane & 7;
    f32x4 v[8], vn[8];
    { const int kb = item0 / nblk, nb = item0 % nblk; const float* src = W + (size_t)(64 * kb + lr) * N + 32 * nb + lc;
#pragma unroll
      for (int i = 0; i < 8; ++i) v[i] = *(const GAS f32x4*)(src + (size_t)(8 * i) * N); }
#pragma unroll 1
    for (int it = 0; it < nitems; ++it) {
        const int item = item0 + it, kb = item / nblk, nb = item % nblk, k0 = 64 * kb, n0 = 32 * nb;
        if (it + 1 < nitems) { const int kb2 = (item + 1) / nblk, nb2 = (item + 1) % nblk; const float* src = W + (size_t)(64 * kb2 + lr) * N + 32 * nb2 + lc;
#pragma unroll
            for (int i = 0; i < 8; ++i) vn[i] = *(const GAS f32x4*)(src + (size_t)(8 * i) * N); }
#pragma unroll
        for (int i = 0; i < 8; ++i) { LAS float* d = scr + (lr + 8 * i) * 33 + lc; d[0] = v[i].x; d[1] = v[i].y; d[2] = v[i].z; d[3] = v[i].w; }
        LDS_WAIT(); asm volatile("" ::: "memory");
#pragma unroll
        for (int j = 0; j < 4; ++j) { const int n = (lane >> 3) + 8 * j; const LAS float* s = scr + (8 * c) * 33 + n;
            v4u o; o.x = pk2(s[0 * 33], s[1 * 33]); o.y = pk2(s[2 * 33], s[3 * 33]); o.z = pk2(s[4 * 33], s[5 * 33]); o.w = pk2(s[6 * 33], s[7 * 33]);
            int nn = n0 + n; if (GLU) { const int jj = nn >> 1; nn = 256 * (jj >> 7) + 128 * (nn & 1) + (jj & 127); }
            *(GAS v4u*)(WT + (size_t)nn * K + k0 + 8 * c) = o; }
        LDS_WAIT(); asm volatile("" ::: "memory");
#pragma unroll
        for (int i = 0; i < 8; ++i) v[i] = vn[i];
    }
}
__device__ __forceinline__ void rms_row_to_bf16(const float* xrow, const float* gain, bf16* orow, int lane) {
    const GAS f32x4* xr = (const GAS f32x4*)xrow + lane; const GAS f32x4* gr = (const GAS f32x4*)gain + lane;
    f32x4 v[4]; float s = 0.f;
#pragma unroll
    for (int j = 0; j < 4; ++j) { v[j] = xr[64 * j]; s += (v[j].x * v[j].x + v[j].y * v[j].y) + (v[j].z * v[j].z + v[j].w * v[j].w); }
    const float rstd = 1.f / sqrtf(wave_sum(s) * (1.f / DM) + NORM_EPS);
    GAS unsigned long long* o8 = (GAS unsigned long long*)orow + lane;
#pragma unroll
    for (int j = 0; j < 4; ++j) { const f32x4 g = gr[64 * j]; o8[64 * j] = (unsigned long long)pk2(v[j].x * rstd * g.x, v[j].y * rstd * g.y) | ((unsigned long long)pk2(v[j].z * rstd * g.z, v[j].w * rstd * g.w) << 32); }
}

__global__ void __launch_bounds__(NWAVES * 64, 2) mk_fwd(Args args) {
    extern __shared__ __attribute__((aligned(16))) unsigned char lds_raw[];
    LAS unsigned char* const lds = (LAS unsigned char*)lds_raw;
    volatile LAS unsigned* const MISC = (volatile LAS unsigned*)(lds + MISC_OFF);
    const int tid = threadIdx.x, lane = tid & 63, wave = __builtin_amdgcn_readfirstlane(tid >> 6);
    const int G = gridDim.x; const int bx = blockIdx.x; const int vcu = (G % 8 == 0) ? (bx % 8) * (G / 8) + bx / 8 : bx;
    unsigned char* const ws = args.ws;
    gu32* const ctl = (gu32*)(ws + WS_CTL);
    bf16* const Win_t = (bf16*)(ws + WS_WIN); bf16* const Wout_t = (bf16*)(ws + WS_WOUT); bf16* const Wpg_t = (bf16*)(ws + WS_WPG); bf16* const Wpp_t = (bf16*)(ws + WS_WPP);
    bf16* const Wgu_t = (bf16*)(ws + WS_WGU); bf16* const Wdn_t = (bf16*)(ws + WS_WDN);
    bf16* const XN = (bf16*)(ws + WS_XN); bf16* const OB = (bf16*)(ws + WS_O); bf16* const PROJ = (bf16*)(ws + WS_PROJ);
    float* const H1 = (float*)(ws + WS_H1); float* const PERAW = (float*)(ws + WS_PERAW); bf16* const PE16 = (bf16*)(ws + WS_PE16); bf16* const P16 = (bf16*)(ws + WS_P16);
    bf16* const ACT = (bf16*)(ws + WS_ACT); bf16* const YB = (bf16*)(ws + WS_Y);
    int* const TINFO = (int*)(ws + WS_TINFO); int* const LIST = (int*)(ws + WS_LIST); float* const LGATE = (float*)(ws + WS_LGATE);

    for (int u = tid; u < (LDS_BYTES - MISC_OFF) / 4; u += NWAVES * 64) ((LAS unsigned*)(lds + MISC_OFF))[u] = 0u;
    __syncthreads();
    XcdBarrier bar; bar.bar = (unsigned*)(ctl + CW_BAR); bar.x = 0; bar.st = nullptr;
    if (MK_N_LAUNCHES == 1) bar = xcd_barrier_post((unsigned*)(ctl + CW_BAR), MISC + 8);
    const int lo = args.ph_lo, hi = args.ph_hi;
#define IN(k) (lo <= (k) && (k) < hi)
#define SEAM(k) do { if (IN(k) && IN((k) + 1)) xcd_barrier(bar); } while (0)
#define REPS(k) for (int rep = 0; rep < ((MK_REP == (k)) ? 2 : 1); ++rep)
#define REPBAR(k) do { if (MK_REP == (k) && rep == 0) xcd_barrier(bar); } while (0)

    if (IN(0)) REPS(0) {
        LAS float* scr = (LAS float*)(lds + wave * 16384);
        const int gw = vcu * NWAVES + wave, NGW = G * NWAVES;
        constexpr int I_IN = (DM / 64) * (NIN / 32), I_SQ = (DM / 64) * (DM / 32), I_PP = (PLE / 64) * (DM / 32);
        constexpr int NITEMS = I_IN + 2 * I_SQ + I_PP;
        for (int it = gw; it < NITEMS; it += NGW) {
            int r = it;
            if (r < I_IN) { conv_items<false>(args.w_in, DM, NIN, Win_t, scr, r, 1, lane); continue; } r -= I_IN;
            if (r < I_SQ) { conv_items<false>(args.w_out, DM, DM, Wout_t, scr, r, 1, lane); continue; } r -= I_SQ;
            if (r < I_SQ) { conv_items<false>(args.ple_gate, DM, DM, Wpg_t, scr, r, 1, lane); continue; } r -= I_SQ;
            conv_items<false>(args.ple_proj, PLE, DM, Wpp_t, scr, r, 1, lane);
        }
        for (int m = gw; m < M; m += NGW) {
            rms_row_to_bf16(args.x + (size_t)m * DM, args.attn_norm, XN + (size_t)m * DM, lane);
            const f32x4 pv4 = *((const GAS f32x4*)(args.p + (size_t)m * PLE) + lane);
            *((GAS unsigned long long*)(P16 + (size_t)m * PLE) + lane) = (unsigned long long)pk2(pv4.x, pv4.y) | ((unsigned long long)pk2(pv4.z, pv4.w) << 32);
        }
        REPBAR(0);
    }
    SEAM(0);

    if (IN(1)) REPS(1) {
        pg8::DenseOrder S; S.init(XN, Win_t, M, NIN, DM, G, bx);
        pg8::EpiProj E{PROJ};
        pg8::gemm_phase<pg8::EpiProj, pg8::DenseOrder, true>(lds, S, E);
        REPBAR(1);
    }
    SEAM(1);

    if (IN(2)) {
        float lam;
        { const float a = wave_sum(args.lq1[lane] * args.lk1[lane]), c = wave_sum(args.lq2[lane] * args.lk2[lane]); lam = expf(a) - expf(c) + LAMBDA_INIT; }
        REPS(2) { for (;;) {
            if (tid == 0) MISC[16] = __hip_atomic_fetch_add(ctl + CW_ATTQ + 64 * rep, 1u, RLX_AGENT);
            __syncthreads();
            const int qi = (int)MISC[16];
            __syncthreads();
            if (qi >= 1536) break;
            const int u = qi >> 1;
            if (qi & 1) {
                LAS float* scr = (LAS float*)(lds + wave * 16384);
                if (u < 512) { const int e = u >> 4, kb = u & 15; conv_items<true>(args.w_gu + (size_t)e * DM * 2048, DM, 2048, Wgu_t + (size_t)e * 2048 * DM, scr, kb * 64 + wave * 8, 8, lane); }
                else { const int c2 = u - 512, e = c2 >> 3; conv_items<false>(args.w_dn + (size_t)e * DM * DM, DM, DM, Wdn_t + (size_t)e * DM * DM, scr, (c2 & 7) * 64 + wave * 8, 8, lane); }
                continue;
            }
            const int qb = 7 - u / 96, g = u % 96;
            if (g < 32) att::diff_unit(g >> 2, g & 3, qb, PROJ, OB, args.rel_bias, args.subln, lam, lds);
            else att::sb_unit((g - 32) >> 3, (g - 32) & 7, qb, PROJ, OB, lds);
        } REPBAR(2); }
    }
    SEAM(2);

    if (IN(3)) REPS(3) {
        { pg8::DenseOrder S; S.init(OB, Wout_t, M, DM, DM, G, bx); pg8::EpiResF32 E{args.x, H1};
          pg8::gemm_phase<pg8::EpiResF32, pg8::DenseOrder, false>(lds, S, E); }
        if (MK_PIPE >= 3) { pg8::DenseOrder S; S.init(P16, Wpp_t, M, DM, PLE, G, bx); pg8::EpiResF32 E{nullptr, PERAW};
          pg8::gemm_phase<pg8::EpiResF32, pg8::DenseOrder, false>(lds, S, E); }
        REPBAR(3);
    }
    SEAM(3);

    if (IN(4) && MK_PIPE >= 2) {
        LAS float* xs = (LAS float*)(lds + wave * 16384);
        LAS int* lcnt = (LAS int*)(lds + TAB_OFF + 512);
        LAS int* lbase = lcnt + 32;
        LAS int* pend = (LAS int*)(lds + TAB_OFF + 1024);
        for (int tile = bx; tile < M / 64; tile += G) {
            if (tid < 32) lcnt[tid] = 0;
            __syncthreads();
            for (int pass = 0; pass < 2; ++pass) {
                const int row0 = tile * 64 + wave * 8 + pass * 4;
#pragma unroll 1
                for (int r = 0; r < 4; ++r) {
                    const int m = row0 + r;
                    const GAS f32x4* xr = (const GAS f32x4*)(H1 + (size_t)m * DM) + lane; const GAS f32x4* gr = (const GAS f32x4*)args.moe_norm + lane;
                    f32x4 v[4]; float s = 0.f;
#pragma unroll
                    for (int j = 0; j < 4; ++j) { v[j] = xr[64 * j]; s += (v[j].x * v[j].x + v[j].y * v[j].y) + (v[j].z * v[j].z + v[j].w * v[j].w); }
                    const float rstd = 1.f / sqrtf(wave_sum(s) * (1.f / DM) + NORM_EPS);
                    GAS unsigned long long* o8 = (GAS unsigned long long*)(XN + (size_t)m * DM) + lane;
#pragma unroll
                    for (int j = 0; j < 4; ++j) { const f32x4 g = gr[64 * j]; const f32x4 y = (f32x4){v[j].x * rstd * g.x, v[j].y * rstd * g.y, v[j].z * rstd * g.z, v[j].w * rstd * g.w};
                        o8[64 * j] = (unsigned long long)pk2(y.x, y.y) | ((unsigned long long)pk2(y.z, y.w) << 32);
                        const int kb = 4 * lane + 256 * j;
                        xs[(kb + 0) * 4 + r] = y.x; xs[(kb + 1) * 4 + r] = y.y; xs[(kb + 2) * 4 + r] = y.z; xs[(kb + 3) * 4 + r] = y.w; }
                }
                LDS_WAIT(); asm volatile("" ::: "memory");
                const int e = lane & 31, kh = lane >> 5;
                float a0 = 0.f, a1 = 0.f, a2 = 0.f, a3 = 0.f;
                const float* wp = args.router_w + (size_t)(kh * 512) * NEXP + e;
                const LAS f32x4* xp = (const LAS f32x4*)xs + kh * 512;
#pragma unroll 8
                for (int k = 0; k < 512; ++k) { const float w = wp[(size_t)k * NEXP]; const f32x4 xv = xp[k]; a0 += w * xv.x; a1 += w * xv.y; a2 += w * xv.z; a3 += w * xv.w; }
                a0 += __shfl_xor(a0, 32); a1 += __shfl_xor(a1, 32); a2 += __shfl_xor(a2, 32); a3 += __shfl_xor(a3, 32);
                const float rb = args.router_b[e];
                float lg[4] = {a0 + rb, a1 + rb, a2 + rb, a3 + rb};
#pragma unroll
                for (int r = 0; r < 4; ++r) {
                    float v = lg[r]; float tv[4]; int ti[4];
#pragma unroll
                    for (int k = 0; k < 4; ++k) {
                        float bv = v; int bi = e;
#pragma unroll
                        for (int o = 1; o < 32; o <<= 1) { const float ov = __shfl_xor(bv, o); const int oi = __shfl_xor(bi, o); if (ov > bv || (ov == bv && oi < bi)) { bv = ov; bi = oi; } }
                        tv[k] = bv; ti[k] = bi; if (e == bi) v = -INFINITY;
                    }
                    const float e1 = __expf(tv[1] - tv[0]), e2 = __expf(tv[2] - tv[0]), e3 = __expf(tv[3] - tv[0]); const float inv = 1.0f / (1.0f + e1 + e2 + e3);
                    if (lane < 4) { const int k = lane; const int ek = k == 0 ? ti[0] : k == 1 ? ti[1] : k == 2 ? ti[2] : ti[3]; const float gk = (k == 0 ? 1.0f : k == 1 ? e1 : k == 2 ? e2 : e3) * inv;
                        const int rank = __hip_atomic_fetch_add(lcnt + ek, 1, __ATOMIC_RELAXED, __HIP_MEMORY_SCOPE_WORKGROUP);
                        const int pi = ((wave * 2 + pass) * 4 + r) * 4 + k;
                        pend[pi * 4 + 0] = (row0 + r) * 4 + k; pend[pi * 4 + 1] = ek; pend[pi * 4 + 2] = rank; pend[pi * 4 + 3] = (int)__float_as_uint(gk); }
                }
                LDS_WAIT(); asm volatile("" ::: "memory");
            }
            __syncthreads();
            if (tid < 32) { const int c = lcnt[tid]; lbase[tid] = c > 0 ? (int)__hip_atomic_fetch_add(ctl + CW_GCNT + 64 * tid, (unsigned)c, RLX_AGENT) : 0; }
            __syncthreads();
            if (tid < 256) { const int tk = pend[tid * 4 + 0], ek = pend[tid * 4 + 1], rank = pend[tid * 4 + 2]; const float gk = __uint_as_float((unsigned)pend[tid * 4 + 3]);
                const int pos = lbase[ek] + rank;
                LIST[ek * LCAP + pos] = tk >> 2; LGATE[ek * LCAP + pos] = gk; TINFO[tk] = (pos << 5) | ek; }
            __syncthreads();
        }
    }
    SEAM(4);

    LAS int* const tp = (LAS int*)(lds + TAB_OFF); LAS int* const ecnt = tp + 40;
    if ((IN(5) || IN(6) || IN(7)) && MK_PIPE >= 2) {
        if (tid < 32) ecnt[tid] = (int)__hip_atomic_load(ctl + CW_GCNT + 64 * tid, RLX_AGENT);
        __syncthreads();
        if (tid == 0) { int a = 0; for (int e = 0; e < NEXP; ++e) { tp[e] = a; a += (ecnt[e] + 255) >> 8; } tp[NEXP] = a; }
        __syncthreads();
    }

    if (IN(5) && MK_PIPE >= 2) REPS(5) {
        pg8::GroupedOrder<true, 8, 4> S{XN, Wgu_t, (size_t)2048 * DM * 2, LIST, tp, ecnt, DM, G, bx};
        pg8::EpiGlu E{ACT, args.b_gu};
        pg8::gemm_phase<pg8::EpiGlu, pg8::GroupedOrder<true, 8, 4>, true>(lds, S, E);
        REPBAR(5);
    }
    SEAM(5);

    if (IN(6) && MK_PIPE >= 2) REPS(6) {
        pg8::GroupedOrder<false, 4, 8> S{ACT, Wdn_t, (size_t)DM * DM * 2, LIST, tp, ecnt, DM, G, bx};
        pg8::EpiDown E{YB, args.b_dn, LGATE};
        pg8::gemm_phase<pg8::EpiDown, pg8::GroupedOrder<false, 4, 8>, true>(lds, S, E);
        REPBAR(6);
    }
    SEAM(6);

    if (IN(7) && MK_PIPE >= 2) {
        const int gw = vcu * NWAVES + wave, NGW = G * NWAVES;
        for (int m = gw; m < M; m += NGW) {
            GAS f32x4* hr = (GAS f32x4*)(H1 + (size_t)m * DM) + lane;
            f32x4 v[4];
#pragma unroll
            for (int j = 0; j < 4; ++j) v[j] = hr[64 * j];
#pragma unroll
            for (int k = 0; k < 4; ++k) { const int ti = TINFO[m * 4 + k]; const int e = ti & 31, pos = ti >> 5; const size_t slot = (size_t)tp[e] * 256 + pos;
                const GAS u32x2* yr = (const GAS u32x2*)(YB + slot * DM) + lane;
#pragma unroll
                for (int j = 0; j < 4; ++j) { const u32x2 w = yr[64 * j]; v[j].x += bf_lo(w.x); v[j].y += bf_hi(w.x); v[j].z += bf_lo(w.y); v[j].w += bf_hi(w.y); } }
            GAS unsigned long long* o8 = (GAS unsigned long long*)(XN + (size_t)m * DM) + lane;
#pragma unroll
            for (int j = 0; j < 4; ++j) { hr[64 * j] = v[j]; o8[64 * j] = (unsigned long long)pk2(v[j].x, v[j].y) | ((unsigned long long)pk2(v[j].z, v[j].w) << 32); }
            if (MK_PIPE >= 3) rms_row_to_bf16(PERAW + (size_t)m * DM, args.ple_norm, PE16 + (size_t)m * DM, lane);
        }
    }
    SEAM(7);

    if (IN(8) && MK_PIPE >= 3) REPS(8) {
        pg8::DenseOrder S; S.init(XN, Wpg_t, M, DM, DM, G, bx);
        pg8::EpiPle E{H1, PE16, args.out};
        pg8::gemm_phase<pg8::EpiPle, pg8::DenseOrder, false>(lds, S, E);
        REPBAR(8);
    }
    SEAM(8);

    if (IN(9)) {
        const int gw = vcu * NWAVES + wave, NGW = G * NWAVES;
        const float* src = (MK_PIPE >= 3) ? args.out : H1;
        for (int m = gw; m < M; m += NGW) {
            const GAS f32x4* xr = (const GAS f32x4*)(src + (size_t)m * DM) + lane; const GAS f32x4* gr = (const GAS f32x4*)args.final_norm + lane;
            f32x4 v[4]; float s = 0.f;
#pragma unroll
            for (int j = 0; j < 4; ++j) { v[j] = xr[64 * j]; s += (v[j].x * v[j].x + v[j].y * v[j].y) + (v[j].z * v[j].z + v[j].w * v[j].w); }
            const float rstd = 1.f / sqrtf(wave_sum(s) * (1.f / DM) + NORM_EPS);
            GAS f32x4* orow = (GAS f32x4*)(args.out + (size_t)m * DM) + lane;
#pragma unroll
            for (int j = 0; j < 4; ++j) { const f32x4 g = gr[64 * j]; orow[64 * j] = (f32x4){v[j].x * rstd * g.x, v[j].y * rstd * g.y, v[j].z * rstd * g.z, v[j].w * rstd * g.w}; }
        }
    }
#undef IN
#undef SEAM
}

extern "C" void kernel_launch(void* const* d_in, const int* in_sizes, int n_in, void* d_out, int out_size, void* d_ws, size_t ws_size, hipStream_t stream) {
    static int grid = 0;
    if (grid == 0) {
        if (n_in != 22 || in_sizes[0] != M * DM || out_size != M * DM || ws_size < WS_END) { fprintf(stderr, "kernel_launch: unexpected shapes (n_in %d, in0 %d, out %d, ws %zu); nothing launched\n", n_in, n_in > 0 ? in_sizes[0] : -1, out_size, ws_size); grid = -1; return; }
        int dev = 0, cus = 0, per_cu = 0;
        if (hipGetDevice(&dev) != hipSuccess || hipDeviceGetAttribute(&cus, hipDeviceAttributeMultiprocessorCount, dev) != hipSuccess) { grid = -1; return; }
        if (hipFuncSetAttribute((const void*)mk_fwd, hipFuncAttributeMaxDynamicSharedMemorySize, LDS_BYTES) != hipSuccess) { fprintf(stderr, "kernel_launch: hipFuncSetAttribute failed\n"); grid = -1; return; }
        if (hipOccupancyMaxActiveBlocksPerMultiprocessor(&per_cu, (const void*)mk_fwd, NWAVES * 64, LDS_BYTES) != hipSuccess || per_cu < 1) fprintf(stderr, "kernel_launch: occupancy query reports %d\n", per_cu);
        (void)hipGetLastError();
        grid = cus;
        if (grid != 256) { fprintf(stderr, "kernel_launch: built for a 256-CU device, found %d CUs; nothing launched\n", cus); grid = -1; return; }
    }
    if (grid < 0) return;
    if (hipMemsetAsync((char*)d_ws + WS_CTL, 0, CTL_ZERO_BYTES, stream) != hipSuccess) return;
    Args a{};
    a.x = (const float*)d_in[0]; a.p = (const float*)d_in[1]; a.w_in = (const float*)d_in[2]; a.w_out = (const float*)d_in[3]; a.attn_norm = (const float*)d_in[4]; a.moe_norm = (const float*)d_in[5];
    a.rel_bias = (const float*)d_in[6]; a.lq1 = (const float*)d_in[7]; a.lk1 = (const float*)d_in[8]; a.lq2 = (const float*)d_in[9]; a.lk2 = (const float*)d_in[10]; a.subln = (const float*)d_in[11];
    a.router_w = (const float*)d_in[12]; a.router_b = (const float*)d_in[13]; a.w_gu = (const float*)d_in[14]; a.b_gu = (const float*)d_in[15]; a.w_dn = (const float*)d_in[16]; a.b_dn = (const float*)d_in[17];
    a.ple_proj = (const float*)d_in[18]; a.ple_norm = (const float*)d_in[19]; a.ple_gate = (const float*)d_in[20]; a.final_norm = (const float*)d_in[21];
    a.out = (float*)d_out; a.ws = (unsigned char*)d_ws;
    for (int li = 0; li < MK_N_LAUNCHES; ++li) {
        a.ph_lo = (MK_N_LAUNCHES == 1) ? 0 : li; a.ph_hi = (MK_N_LAUNCHES == 1) ? N_PHASES : li + 1;
        hipLaunchKernelGGL(mk_fwd, dim3(grid), dim3(NWAVES * 64), LDS_BYTES, stream, a);
        const hipError_t le = hipPeekAtLastError();
        if (le != hipSuccess) { fprintf(stderr, "kernel_launch: launch %d failed: %s\n", li, hipGetErrorName(le)); break; }
    }
}
```

```cpp
#include <hip/hip_runtime.h>
#include <cstdio>
#include <cstdint>

#ifndef MK_N_LAUNCHES
#define MK_N_LAUNCHES 1
#endif
#ifndef MK_PIPE
#define MK_PIPE 3
#endif

#ifndef MK_REP
#define MK_REP -1
#endif
#define LAS __attribute__((address_space(3)))
#define GAS __attribute__((address_space(1)))
typedef unsigned short bf16;
typedef short bf16x8 __attribute__((ext_vector_type(8)));
typedef short s16x4 __attribute__((ext_vector_type(4)));
typedef short v4i16_t __attribute__((ext_vector_type(4)));
typedef float f32x2 __attribute__((ext_vector_type(2)));
typedef float f32x4 __attribute__((ext_vector_type(4)));
typedef float f32x16 __attribute__((ext_vector_type(16)));
typedef unsigned u32x2 __attribute__((ext_vector_type(2)));
typedef unsigned u32x4 __attribute__((ext_vector_type(4)));
typedef unsigned v4u __attribute__((ext_vector_type(4)));
typedef GAS unsigned gu32;

constexpr int NBATCH = 8, SEQ = 2048, DM = 1024, M = NBATCH * SEQ, NIN = 3072, NEXP = 32, TOPK = 4, PLE = 256;
constexpr int LCAP = 16384;
constexpr int MAXTILES = 288;
constexpr float NORM_EPS = 1e-6f;
constexpr float LOG2E = 1.4426950408889634f;
constexpr float C2 = 0.125f * LOG2E;
constexpr float LAMBDA_INIT = 0.2f;
constexpr int C_Q1 = 0, C_Q2 = 256, C_K1 = 512, C_K2 = 768, C_DV = 1024, C_SQ = 1536, C_SK = 2048, C_SV = 2560;

constexpr size_t MiB = 1u << 20;
constexpr size_t WS_CTL = 0, CTL_ZERO_BYTES = 1 * MiB;
constexpr size_t WS_TINFO = 1 * MiB;
constexpr size_t WS_LIST = 2 * MiB;
constexpr size_t WS_LGATE = 4 * MiB;
constexpr size_t WS_WIN = 6 * MiB;
constexpr size_t WS_WOUT = 12 * MiB;
constexpr size_t WS_WPG = 14 * MiB;
constexpr size_t WS_WPP = 16 * MiB;
constexpr size_t WS_WG = 17 * MiB;
constexpr size_t WS_PESS = 18 * MiB;
constexpr size_t WS_XN = 20 * MiB;
constexpr size_t WS_O = 52 * MiB;
constexpr size_t WS_PROJ = 84 * MiB;
constexpr size_t WS_H1 = 180 * MiB;
constexpr size_t WS_PERAW = 244 * MiB;
constexpr size_t WS_PE16 = 308 * MiB;
constexpr size_t WS_P16 = 340 * MiB;
constexpr size_t WS_WGU = 352 * MiB;
constexpr size_t WS_WDN = 480 * MiB;
constexpr size_t WS_ACT = 544 * MiB;
constexpr size_t WS_Y = 688 * MiB;
constexpr size_t WS_END = 832 * MiB;
constexpr int CW_ATTQ = 64;
constexpr int CW_GCNT = 1024;
constexpr int CW_BAR = 4096;

constexpr int RING_BYTES = 131072;
constexpr int MISC_OFF = RING_BYTES;
constexpr int TAB_OFF = RING_BYTES + 256;
constexpr int LDS_BYTES = 147456;

constexpr int NWAVES = 8;
constexpr int N_PHASES = 10;

#define RLX_AGENT __ATOMIC_RELAXED, __HIP_MEMORY_SCOPE_AGENT
#define LDS_WAIT() asm volatile("s_waitcnt lgkmcnt(0)" ::: "memory")
#define VM_WAIT() asm volatile("s_waitcnt vmcnt(0)" ::: "memory")
__device__ __forceinline__ unsigned f2bf(float f) { unsigned u = __builtin_bit_cast(unsigned, f); return (u + 0x7fffu + ((u >> 16) & 1u)) >> 16; }
__device__ __forceinline__ unsigned pk2(float lo, float hi) { return f2bf(lo) | (f2bf(hi) << 16); }
__device__ __forceinline__ unsigned cvt_pk_bf16(float lo, float hi) { unsigned r; asm volatile("v_cvt_pk_bf16_f32 %0, %1, %2" : "=v"(r) : "v"(lo), "v"(hi)); return r; }
__device__ __forceinline__ float bf_lo(unsigned w) { return __builtin_bit_cast(float, w << 16); }
__device__ __forceinline__ float bf_hi(unsigned w) { return __builtin_bit_cast(float, w & 0xffff0000u); }
__device__ __forceinline__ float wave_sum(float v) {
#pragma unroll
    for (int o = 1; o < 64; o <<= 1) v += __shfl_xor(v, o);
    return v;
}
__device__ __forceinline__ float fast_sigmoid(float a) { return __builtin_amdgcn_rcpf(1.0f + __builtin_amdgcn_exp2f(-a * LOG2E)); }

namespace pg8 {
constexpr int BM = 256, BK = 64, HALF = 128, HTB = HALF * BK * 2, STAGE_BYTES = 8 * HTB, NXCD = 8, WGM = 8;
__host__ __device__ __forceinline__ int lds_byte(int r, int c) { const int st = (r >> 4) * 2 + (c >> 5), rr = r & 15, cc = c & 31, ob = rr * 64 + cc * 2; return st * 1024 + (ob ^ (((ob >> 9) & 1) << 5)); }
__host__ __device__ __forceinline__ void stage_rc(int b, int& R, int& C) { const int st = b / 1024, sb = b % 1024, swz = sb ^ (((sb >> 9) & 1) << 5); R = (st >> 1) * 16 + swz / 64; C = (st & 1) * 32 + (swz % 64) / 2; }
__host__ __device__ __forceinline__ int perm32(int rho) { const int n = rho >> 4, i = rho & 15; return 8 * (i >> 2) + 4 * n + (i & 3); }

struct Unit { int pm, pn, e, T; };

struct DenseOrder {
    const bf16* A; const bf16* Bt; int K, nM, nN, nwg, G, c;
    __device__ __forceinline__ void init(const bf16* A_, const bf16* Bt_, int M_, int N_, int K_, int G_, int c_) { A = A_; Bt = Bt_; K = K_; nM = M_ / BM; nN = N_ / BM; nwg = nM * nN; G = G_; c = c_; }
    __device__ __forceinline__ bool next(int i, Unit& u) const {
        const long L = (long)i * G + c; if (L >= nwg) return false;
        int wgid = (int)L; { const int q = nwg / NXCD, r = nwg % NXCD, xcd = wgid % NXCD, off = wgid / NXCD; wgid = (xcd < r ? xcd * (q + 1) : r * (q + 1) + (xcd - r) * q) + off; }
        const int nig = WGM * nN, gid = wgid / nig, fm = gid * WGM, gsz = (nM - fm) < WGM ? (nM - fm) : WGM;
        u.pm = fm + ((wgid % nig) % gsz); u.pn = (wgid % nig) / gsz; u.e = 0; u.T = u.pm; return true;
    }
    __device__ __forceinline__ const char* a_base() const { return (const char*)A; }
    __device__ __forceinline__ unsigned a_row(const Unit& u, int r) const { return (unsigned)(u.T * BM + r); }
    __device__ __forceinline__ const char* b_ptr(const Unit& u) const { return (const char*)Bt + (size_t)u.pn * BM * K * 2; }
};

template <bool GATHER, int NN  , int TPX  >
struct GroupedOrder {
    const bf16* A; const bf16* Bt; size_t b_estride; const int* list; const LAS int* tp; const LAS int* cnt; int K, G, c;
    __device__ __forceinline__ bool next(int i, Unit& u) const {
        const int tiles = tp[NEXP];
        const int L = i * G + c, round = L >> 8, w = L & 255, x = w & 7, j = w >> 3;
        const int T = round * (8 * TPX) + x * TPX + j / NN; if (T >= tiles) return false;
        int e = 0;
#pragma unroll 1
        for (int k = 16; k >= 1; k >>= 1) { if (tp[e + k] <= T) e += k; }
        u.e = __builtin_amdgcn_readfirstlane(e); u.T = __builtin_amdgcn_readfirstlane(T); u.pm = u.T - __builtin_amdgcn_readfirstlane(tp[u.e]); u.pn = j % NN; return true;
    }
    __device__ __forceinline__ const char* a_base() const { return (const char*)A; }
    __device__ __forceinline__ unsigned a_row(const Unit& u, int r) const {
        if constexpr (GATHER) { const int idx = u.pm * BM + r; return (idx < cnt[u.e]) ? (unsigned)list[u.e * LCAP + idx] : 0u; }
        else return (unsigned)(u.T * BM + r);
    }
    __device__ __forceinline__ const char* b_ptr(const Unit& u) const { return (const char*)Bt + (size_t)u.e * b_estride + (size_t)u.pn * BM * K * 2; }
};

template <class Epi, class Sched, bool ALIGN_EPI>
__device__ __forceinline__ void gemm_phase(LAS unsigned char* lds, const Sched& S, const Epi& E) {
    const int tid = threadIdx.x, wid = __builtin_amdgcn_readfirstlane(tid >> 6), lane = tid & 63, wr = wid >> 2, wc = wid & 3, fr = lane & 15, fq = lane >> 4;
    const int K = S.K, nt = K / BK;
    int RA[2], CA[2]; unsigned voffB[2];
#pragma unroll
    for (int i = 0; i < 2; ++i) { int R, C; stage_rc(tid * 16 + i * 8192, R, C); const int Rb = Epi::PERM ? ((R & ~31) + perm32(R & 31)) : R;
        RA[i] = R; CA[i] = C; voffB[i] = (unsigned)(Rb * K + C) * 2u; }
    const size_t kstep = (size_t)(BK * 2);
    const size_t hstep = (size_t)HALF * K * 2;
    const unsigned ldsw = (unsigned)wid * 1024u;
    const int aoff = lds_byte(wr * 64 + fr, fq * 8), boff = lds_byte(wc * 32 + fr, fq * 8);
#define PG8_SA(b, h) (((b) * 2 + (h)) * HTB)
#define PG8_SB(b, h) ((4 + (b) * 2 + (h)) * HTB)
#define PG8_STAGE(bufoff, gbase, voff) do { _Pragma("unroll") for (int _i = 0; _i < 2; ++_i) \
        __builtin_amdgcn_global_load_lds((const unsigned*)((const char*)(gbase) + (voff)[_i]), (LAS unsigned*)(lds + (bufoff) + ldsw + _i * 8192), 16, 0, 0); } while (0)
#define PG8_LDA(dst, b, h) do { _Pragma("unroll") for (int m = 0; m < 4; ++m) _Pragma("unroll") for (int k = 0; k < 2; ++k) dst[m][k] = *(const LAS bf16x8*)(lds + PG8_SA(b, h) + aoff + m * 2048 + k * 1024); } while (0)
#define PG8_LDB(dst, b, h) do { _Pragma("unroll") for (int n = 0; n < 2; ++n) _Pragma("unroll") for (int k = 0; k < 2; ++k) dst[n][k] = *(const LAS bf16x8*)(lds + PG8_SB(b, h) + boff + n * 2048 + k * 1024); } while (0)
#define PG8_MMA(ai, bj, At, Bt) do { __builtin_amdgcn_s_setprio(1); _Pragma("unroll") for (int m = 0; m < 4; ++m) _Pragma("unroll") for (int n = 0; n < 2; ++n) _Pragma("unroll") for (int k = 0; k < 2; ++k) \
        acc[ai][bj][m][n] = __builtin_amdgcn_mfma_f32_16x16x32_bf16(Bt[n][k], At[m][k], acc[ai][bj][m][n], 0, 0, 0); __builtin_amdgcn_s_setprio(0); } while (0)
#define PG8_WAIT_V(n) asm volatile("s_waitcnt vmcnt(" #n ")" ::: "memory")
#define PG8_WAIT_L(n) asm volatile("s_waitcnt lgkmcnt(" #n ")" ::: "memory")
#define PG8_BAR __builtin_amdgcn_s_barrier()
#define PG8_SCHED __builtin_amdgcn_sched_barrier(0)
    Unit cur, nxt, nx2; int ui = 0;
    if (!S.next(0, cur)) return;
    bool has_next = S.next(1, nxt);
    unsigned vcur[2][2], vnxt[2][2];
#pragma unroll
    for (int h = 0; h < 2; ++h)
#pragma unroll
        for (int i = 0; i < 2; ++i) vcur[h][i] = (S.a_row(cur, h * HALF + RA[i]) * (unsigned)K + (unsigned)CA[i]) * 2u;
#pragma unroll
    for (int h = 0; h < 2; ++h)
#pragma unroll
        for (int i = 0; i < 2; ++i) vnxt[h][i] = has_next ? (S.a_row(nxt, h * HALF + RA[i]) * (unsigned)K + (unsigned)CA[i]) * 2u : vcur[h][i];
    f32x4 acc[2][2][4][2];
#pragma unroll
    for (int a = 0; a < 2; ++a)
#pragma unroll
        for (int b = 0; b < 2; ++b)
#pragma unroll
            for (int m = 0; m < 4; ++m)
#pragma unroll
                for (int n = 0; n < 2; ++n) acc[a][b][m][n] = (f32x4){0.f, 0.f, 0.f, 0.f};
    bf16x8 At[4][2], B0[2][2], B1[2][2];
    const char* const abase = S.a_base();
    const char* cB = S.b_ptr(cur);
    PG8_STAGE(PG8_SB(0, 0), cB, voffB); PG8_STAGE(PG8_SB(0, 1), cB + hstep, voffB); PG8_STAGE(PG8_SA(0, 0), abase, vcur[0]); PG8_STAGE(PG8_SA(0, 1), abase, vcur[1]);
    if (wr == 1) PG8_BAR;
    PG8_WAIT_V(2); PG8_BAR;
    PG8_STAGE(PG8_SB(1, 0), cB + kstep, voffB); PG8_STAGE(PG8_SA(1, 0), abase + kstep, vcur[0]); PG8_STAGE(PG8_SB(1, 1), cB + hstep + kstep, voffB);
    PG8_WAIT_V(6); PG8_BAR;
    for (;;) {
        const char* nB = has_next ? S.b_ptr(nxt) : cB;
        for (int t = 0; t < nt; t += 2) {
            const bool last = (t == nt - 2);
            const char* a1 = abase + (size_t)(t + 1) * kstep;
            const char* a2 = last ? abase : abase + (size_t)(t + 2) * kstep; const char* b2 = last ? nB : cB + (size_t)(t + 2) * kstep;
            const char* a3 = a2 + kstep; const char* b3 = b2 + kstep;
            unsigned v2[2][2];
#pragma unroll
            for (int h = 0; h < 2; ++h)
#pragma unroll
                for (int i = 0; i < 2; ++i) v2[h][i] = (last && has_next) ? vnxt[h][i] : vcur[h][i];
            PG8_LDB(B0, 0, 0); PG8_LDB(B1, 0, 1); PG8_SCHED; PG8_LDA(At, 0, 0); PG8_STAGE(PG8_SA(1, 1), a1, vcur[1]);
            PG8_WAIT_V(8); PG8_WAIT_L(0); PG8_BAR; PG8_MMA(0, 0, At, B0); PG8_MMA(0, 1, At, B1); PG8_BAR; PG8_SCHED;
            PG8_LDA(At, 0, 1); PG8_STAGE(PG8_SB(0, 0), b2, voffB); PG8_STAGE(PG8_SB(0, 1), b2 + hstep, voffB); PG8_STAGE(PG8_SA(0, 0), a2, v2[0]);
            PG8_WAIT_V(8); PG8_WAIT_L(0); PG8_BAR; PG8_MMA(1, 0, At, B0); PG8_MMA(1, 1, At, B1); PG8_BAR; PG8_SCHED;
            PG8_LDB(B0, 1, 0); PG8_LDB(B1, 1, 1); PG8_SCHED; PG8_LDA(At, 1, 0); PG8_STAGE(PG8_SA(0, 1), a2, v2[1]);
            PG8_WAIT_V(8); PG8_WAIT_L(0); PG8_BAR; PG8_MMA(0, 0, At, B0); PG8_MMA(0, 1, At, B1); PG8_BAR; PG8_SCHED;
            PG8_LDA(At, 1, 1); PG8_STAGE(PG8_SB(1, 0), b3, voffB); PG8_STAGE(PG8_SB(1, 1), b3 + hstep, voffB); PG8_STAGE(PG8_SA(1, 0), a3, v2[0]);
            PG8_WAIT_V(8); PG8_WAIT_L(0); PG8_BAR; PG8_MMA(1, 0, At, B0); PG8_MMA(1, 1, At, B1); PG8_BAR; PG8_SCHED;
        }
        if constexpr (ALIGN_EPI) { if (wr == 0) PG8_BAR; }
        const bool has_nx2 = has_next && S.next(ui + 2, nx2);
        unsigned raw[2][2];
#pragma unroll
        for (int h = 0; h < 2; ++h)
#pragma unroll
            for (int i = 0; i < 2; ++i) raw[h][i] = has_nx2 ? S.a_row(nx2, h * HALF + RA[i]) : 0u;
        E(acc, cur, wr, wc, fr, fq);
        if (!has_next) break;
#pragma unroll
        for (int a = 0; a < 2; ++a)
#pragma unroll
            for (int b = 0; b < 2; ++b)
#pragma unroll
                for (int m = 0; m < 4; ++m)
#pragma unroll
                    for (int n = 0; n < 2; ++n) acc[a][b][m][n] = (f32x4){0.f, 0.f, 0.f, 0.f};
#pragma unroll
        for (int h = 0; h < 2; ++h)
#pragma unroll
            for (int i = 0; i < 2; ++i) { vcur[h][i] = vnxt[h][i]; if (has_nx2) vnxt[h][i] = (raw[h][i] * (unsigned)K + (unsigned)CA[i]) * 2u; }
        cur = nxt; cB = nB; nxt = nx2; has_next = has_nx2; ++ui;
        if constexpr (ALIGN_EPI) { if (wr == 1) PG8_BAR; }
    }
    PG8_WAIT_V(0);
    if constexpr (!ALIGN_EPI) { if (wr == 0) PG8_BAR; }
    PG8_BAR;
#undef PG8_SA
#undef PG8_SB
#undef PG8_STAGE
#undef PG8_LDA
#undef PG8_LDB
#undef PG8_MMA
#undef PG8_WAIT_V
#undef PG8_WAIT_L
#undef PG8_BAR
#undef PG8_SCHED
}

struct EpiProj {
    static constexpr bool PERM = true;
    bf16* O;
    __device__ __forceinline__ void operator()(const f32x4 (&acc)[2][2][4][2], const Unit& u, int wr, int wc, int fr, int fq) const {
        const int row0 = u.T * BM + wr * 64 + fr, colt = u.pn * BM;
        const float sc = (colt < 512 || (colt >= 1536 && colt < 2048)) ? C2 : 1.0f;
        const int col0 = colt + wc * 32 + 8 * fq;
#pragma unroll
        for (int ai = 0; ai < 2; ++ai)
#pragma unroll
            for (int m = 0; m < 4; ++m) { bf16* rowp = O + (size_t)(row0 + ai * HALF + m * 16) * NIN + col0;
#pragma unroll
                for (int bj = 0; bj < 2; ++bj) { const f32x4 v0 = acc[ai][bj][m][0] * sc, v1 = acc[ai][bj][m][1] * sc;
                    u32x4 w; w.x = cvt_pk_bf16(v0[0], v0[1]); w.y = cvt_pk_bf16(v0[2], v0[3]); w.z = cvt_pk_bf16(v1[0], v1[1]); w.w = cvt_pk_bf16(v1[2], v1[3]);
                    *(u32x4*)(rowp + bj * HALF) = w; } }
    }
};
struct EpiResF32 {
    static constexpr bool PERM = false;
    const float* base; float* out;
    __device__ __forceinline__ void operator()(const f32x4 (&acc)[2][2][4][2], const Unit& u, int wr, int wc, int fr, int fq) const {
        const int col0 = u.pn * BM + wc * 32 + 4 * fq;
#pragma unroll
        for (int ai = 0; ai < 2; ++ai)
#pragma unroll
            for (int m = 0; m < 4; ++m) { const size_t off = (size_t)(u.T * BM + ai * HALF + wr * 64 + m * 16 + fr) * DM + col0;
#pragma unroll
                for (int bj = 0; bj < 2; ++bj)
#pragma unroll
                    for (int n = 0; n < 2; ++n) { f32x4 o = acc[ai][bj][m][n]; if (base) o += *(const f32x4*)(base + off + bj * HALF + n * 16); *(f32x4*)(out + off + bj * HALF + n * 16) = o; }
                if (m & 1) asm volatile("" ::: "memory"); }
    }
};
struct EpiGlu {
    static constexpr bool PERM = true;
    bf16* ACT; const float* bgu;
    __device__ __forceinline__ void operator()(const f32x4 (&acc)[2][2][4][2], const Unit& u, int wr, int wc, int fr, int fq) const {
        const int j0 = u.pn * HALF + wc * 32 + 8 * fq;
        const float* bp = bgu + (size_t)u.e * 2048 + 2 * j0;
        const f32x4 b0 = *(const f32x4*)(bp), b1 = *(const f32x4*)(bp + 4), b2 = *(const f32x4*)(bp + 8), b3 = *(const f32x4*)(bp + 12);
        const float bg[8] = {b0[0], b0[2], b1[0], b1[2], b2[0], b2[2], b3[0], b3[2]};
        const float bl[8] = {b0[1], b0[3], b1[1], b1[3], b2[1], b2[3], b3[1], b3[3]};
#pragma unroll
        for (int ai = 0; ai < 2; ++ai)
#pragma unroll
            for (int m = 0; m < 4; ++m) {
                const size_t row = (size_t)(u.T * BM + ai * HALF + wr * 64 + m * 16 + fr);
                float a[8];
#pragma unroll
                for (int i = 0; i < 8; ++i) {
                    const float g = fminf(acc[ai][0][m][i >> 2][i & 3] + bg[i], 7.0f);
                    const float l = fminf(fmaxf(acc[ai][1][m][i >> 2][i & 3] + bl[i], -7.0f), 7.0f);
                    a[i] = g * fast_sigmoid(1.702f * g) * (l + 1.0f);
                }
                u32x4 w; w.x = cvt_pk_bf16(a[0], a[1]); w.y = cvt_pk_bf16(a[2], a[3]); w.z = cvt_pk_bf16(a[4], a[5]); w.w = cvt_pk_bf16(a[6], a[7]);
                *(u32x4*)(ACT + row * DM + j0) = w;
            }
    }
};
struct EpiDown {
    static constexpr bool PERM = true;
    bf16* Y; const float* bdn; const float* lgate;
    __device__ __forceinline__ void operator()(const f32x4 (&acc)[2][2][4][2], const Unit& u, int wr, int wc, int fr, int fq) const {
        const int col0 = u.pn * BM + wc * 32 + 8 * fq;
        f32x4 bv[2][2];
#pragma unroll
        for (int bj = 0; bj < 2; ++bj)
#pragma unroll
            for (int n = 0; n < 2; ++n) bv[bj][n] = *(const f32x4*)(bdn + (size_t)u.e * DM + col0 + bj * HALF + 4 * n);
#pragma unroll
        for (int ai = 0; ai < 2; ++ai)
#pragma unroll
            for (int m = 0; m < 4; ++m) {
                const int rl = ai * HALF + wr * 64 + m * 16 + fr;
                const float g = lgate[(size_t)u.e * LCAP + u.pm * BM + rl];
                bf16* rowp = Y + (size_t)(u.T * BM + rl) * DM + col0;
#pragma unroll
                for (int bj = 0; bj < 2; ++bj) { const f32x4 v0 = (acc[ai][bj][m][0] + bv[bj][0]) * g, v1 = (acc[ai][bj][m][1] + bv[bj][1]) * g;
                    u32x4 w; w.x = cvt_pk_bf16(v0[0], v0[1]); w.y = cvt_pk_bf16(v0[2], v0[3]); w.z = cvt_pk_bf16(v1[0], v1[1]); w.w = cvt_pk_bf16(v1[2], v1[3]);
                    *(u32x4*)(rowp + bj * HALF) = w; } }
    }
};
struct EpiPeRaw {
    static constexpr bool PERM = true;
    bf16* O; float* pess;
    __device__ __forceinline__ void operator()(const f32x4 (&acc)[2][2][4][2], const Unit& u, int wr, int wc, int fr, int fq) const {
        const int row0 = u.T * BM + wr * 64 + fr, col0 = u.pn * BM + wc * 32 + 8 * fq;
#pragma unroll
        for (int ai = 0; ai < 2; ++ai)
#pragma unroll
            for (int m = 0; m < 4; ++m) { const int row = row0 + ai * HALF + m * 16; bf16* rowp = O + (size_t)row * DM + col0; float sq = 0.f;
#pragma unroll
                for (int bj = 0; bj < 2; ++bj) { const f32x4 v0 = acc[ai][bj][m][0], v1 = acc[ai][bj][m][1];
                    sq += (v0[0] * v0[0] + v0[1] * v0[1]) + (v0[2] * v0[2] + v0[3] * v0[3]) + (v1[0] * v1[0] + v1[1] * v1[1]) + (v1[2] * v1[2] + v1[3] * v1[3]);
                    u32x4 w; w.x = cvt_pk_bf16(v0[0], v0[1]); w.y = cvt_pk_bf16(v0[2], v0[3]); w.z = cvt_pk_bf16(v1[0], v1[1]); w.w = cvt_pk_bf16(v1[2], v1[3]);
                    *(u32x4*)(rowp + bj * HALF) = w; }
                sq += __shfl_xor(sq, 16); sq += __shfl_xor(sq, 32);
                if (fq == 0) pess[(size_t)row * 16 + u.pn * 4 + wc] = sq; }
    }
};
struct EpiPle {
    static constexpr bool PERM = false;
    const float* h2; const bf16* pe; const float* pess; const float* pnorm; float* out;
    __device__ __forceinline__ void operator()(const f32x4 (&acc)[2][2][4][2], const Unit& u, int wr, int wc, int fr, int fq) const {
        const int col0 = u.pn * BM + wc * 32 + 4 * fq;
        f32x4 gn[2][2];
#pragma unroll
        for (int bj = 0; bj < 2; ++bj)
#pragma unroll
            for (int n = 0; n < 2; ++n) gn[bj][n] = *(const f32x4*)(pnorm + col0 + bj * HALF + n * 16);
#pragma unroll
        for (int ai = 0; ai < 2; ++ai)
#pragma unroll
            for (int m = 0; m < 4; ++m) { const int row = u.T * BM + ai * HALF + wr * 64 + m * 16 + fr; const size_t off = (size_t)row * DM + col0;
                const f32x4 s0 = *(const f32x4*)(pess + (size_t)row * 16), s1 = *(const f32x4*)(pess + (size_t)row * 16 + 4), s2 = *(const f32x4*)(pess + (size_t)row * 16 + 8), s3 = *(const f32x4*)(pess + (size_t)row * 16 + 12);
                const float ss = ((s0[0] + s0[1]) + (s0[2] + s0[3])) + ((s1[0] + s1[1]) + (s1[2] + s1[3])) + ((s2[0] + s2[1]) + (s2[2] + s2[3])) + ((s3[0] + s3[1]) + (s3[2] + s3[3]));
                const float rstd = 1.0f / sqrtf(ss * (1.0f / DM) + NORM_EPS);
#pragma unroll
                for (int bj = 0; bj < 2; ++bj)
#pragma unroll
                    for (int n = 0; n < 2; ++n) { const size_t o2 = off + bj * HALF + n * 16; const f32x4 hv = *(const f32x4*)(h2 + o2); const u32x2 pw = *(const u32x2*)(pe + o2); const f32x4 a = acc[ai][bj][m][n]; const f32x4 g = gn[bj][n] * rstd;
                        f32x4 o; o[0] = hv[0] + fast_sigmoid(a[0]) * bf_lo(pw.x) * g[0]; o[1] = hv[1] + fast_sigmoid(a[1]) * bf_hi(pw.x) * g[1]; o[2] = hv[2] + fast_sigmoid(a[2]) * bf_lo(pw.y) * g[2]; o[3] = hv[3] + fast_sigmoid(a[3]) * bf_hi(pw.y) * g[3];
                        *(f32x4*)(out + o2) = o; }
                if (m & 1) asm volatile("" ::: "memory"); }
    }
};
}

namespace att {
constexpr int PITCH = NIN;
constexpr int STAGE = 24576;
constexpr int LDS_TBL = 2 * STAGE;
#define ATT_SBAR() __builtin_amdgcn_sched_barrier(0)
#define ATT_WAIT_BAR() asm volatile("s_waitcnt vmcnt(0) lgkmcnt(0)\n\ts_barrier" ::: "memory")
__device__ __forceinline__ int crow(int r, int hi) { return (r & 3) + 8 * (r >> 2) + 4 * hi; }
__device__ __forceinline__ void glds16(const void* gsrc, unsigned lds_dst) { unsigned keep;
    asm volatile("s_mov_b32 %0, m0\n\ts_mov_b32 m0, %2\n\ts_nop 0\n\tglobal_load_lds_dwordx4 %1, off\n\ts_mov_b32 m0, %0" : "=&s"(keep) : "v"(gsrc), "s"(lds_dst) : "memory"); }
__device__ __forceinline__ s16x4 vtr(const LAS unsigned char* p) { return __builtin_bit_cast(s16x4, __builtin_amdgcn_ds_read_tr16_b64_v4i16((LAS v4i16_t*)p)); }
__device__ __forceinline__ float partner_combine_max(float m) { auto rr = __builtin_amdgcn_permlane32_swap(__float_as_uint(m), __float_as_uint(m), false, false); return fmaxf(__uint_as_float(rr[0]), __uint_as_float(rr[1])); }
__device__ __forceinline__ float partner_combine_sum(float m) { auto rr = __builtin_amdgcn_permlane32_swap(__float_as_uint(m), __float_as_uint(m), false, false); return __uint_as_float(rr[0]) + __uint_as_float(rr[1]); }
__device__ __forceinline__ bf16x8 pack8(const f32x16& p, int b) {
    u32x4 w; w.x = cvt_pk_bf16(p[b], p[b + 1]); w.y = cvt_pk_bf16(p[b + 2], p[b + 3]); w.z = cvt_pk_bf16(p[b + 4], p[b + 5]); w.w = cvt_pk_bf16(p[b + 6], p[b + 7]);
    return __builtin_bit_cast(bf16x8, w);
}
__device__ __forceinline__ void dma_k(const bf16* Ktile, unsigned kdst, int wid, int lane) {
    glds16(Ktile + (size_t)lane * PITCH + wid * 8, (unsigned)__builtin_amdgcn_readfirstlane(kdst + wid * 1024));
}
template <int NVT> __device__ __forceinline__ void dma_v(const bf16* Vtile, unsigned vdst, int wid, int lane) {
#pragma unroll
    for (int q = 0; q < NVT / 2; ++q) { const int p = wid + 8 * q;
        glds16(Vtile + (size_t)(16 * (p & 3) + (lane >> 2)) * PITCH + (p >> 2) * 32 + (lane & 3) * 8, (unsigned)__builtin_amdgcn_readfirstlane(vdst + p * 1024)); }
}
__device__ __forceinline__ void qkt(f32x16& p0, f32x16& p1, const LAS unsigned char* kp, const bf16x8* qf) {
    p0 = f32x16{}; p1 = f32x16{};
#pragma unroll
    for (int d0 = 0; d0 < 4; ++d0) {
        const bf16x8 k0 = *(const LAS bf16x8*)(kp + d0 * 2048), k1 = *(const LAS bf16x8*)(kp + d0 * 2048 + 512);
        p0 = __builtin_amdgcn_mfma_f32_32x32x16_bf16(k0, qf[d0], p0, 0, 0, 0);
        p1 = __builtin_amdgcn_mfma_f32_32x32x16_bf16(k1, qf[d0], p1, 0, 0, 0);
    }
}
template <int NVT> __device__ __forceinline__ void pv(f32x16* o, const LAS unsigned char* vp, const f32x16& p0, const f32x16& p1) {
    const bf16x8 pf0 = pack8(p0, 0), pf1 = pack8(p0, 8), pf2 = pack8(p1, 0), pf3 = pack8(p1, 8);
#pragma unroll
    for (int nt = 0; nt < NVT; ++nt) {
#pragma unroll
        for (int s = 0; s < 4; ++s) {
            const s16x4 lo = vtr(vp + nt * 4096 + s * 1024), hi = vtr(vp + nt * 4096 + s * 1024 + 512);
            const bf16x8 vf = (bf16x8){lo[0], lo[1], lo[2], lo[3], hi[0], hi[1], hi[2], hi[3]};
            o[nt] = __builtin_amdgcn_mfma_f32_32x32x16_bf16(vf, s == 0 ? pf0 : s == 1 ? pf1 : s == 2 ? pf2 : pf3, o[nt], 0, 0, 0);
        }
    }
}

__device__ __forceinline__ float diff_map(f32x16* o, const bf16* Qw, const bf16* Kh, const bf16* Vh, int q0, int wid, int lane, LAS unsigned char* shm, const LAS float* tbl, float c31) {
    const int r32 = lane & 31, hi = lane >> 5;
    const unsigned lds0 = (unsigned)(uintptr_t)shm;
    bf16x8 qf[4];
#pragma unroll
    for (int d0 = 0; d0 < 4; ++d0) qf[d0] = *(const bf16x8*)(Qw + (size_t)r32 * PITCH + d0 * 16 + hi * 8);
#pragma unroll
    for (int d0 = 0; d0 < 4; ++d0) asm volatile("" : "+v"(qf[d0]));
#pragma unroll
    for (int nt = 0; nt < 4; ++nt) o[nt] = f32x16{};
    float mrun = -INFINITY, l = 0.f;
    const int NT = (q0 + 256) / 64;
    const int qlo = q0 + wid * 32, qrow = qlo + r32;
    const LAS unsigned char* kp0 = shm + hi * 1024 + r32 * 16;
    const LAS unsigned char* vp0 = shm + 8192 + ((lane >> 4) & 1) * 32 + (lane & 3) * 8 + (4 * hi + ((lane & 15) >> 2)) * 64;
    dma_k(Kh, lds0, wid, lane); dma_v<4>(Vh, lds0 + 8192, wid, lane);
    for (int t = 0; t < NT; ++t) {
        ATT_WAIT_BAR();
        const int st = (t & 1) * STAGE;
        if (t + 1 < NT) { const int sn = ((t + 1) & 1) * STAGE; dma_k(Kh + (size_t)(t + 1) * 64 * PITCH, lds0 + sn, wid, lane); dma_v<4>(Vh + (size_t)(t + 1) * 64 * PITCH, lds0 + sn + 8192, wid, lane); }
        const int k0 = t * 64;
        if (k0 > qlo + 31) continue;
        f32x16 p0, p1;
        qkt(p0, p1, kp0 + st, qf);
        if (qlo - (k0 + 63) >= 113) {
#pragma unroll
            for (int r = 0; r < 16; ++r) { p0[r] += c31; p1[r] += c31; }
        } else {
            int relb = qrow - k0 - 4 * hi; asm volatile("" : "+v"(relb));
#pragma unroll
            for (int r = 0; r < 16; ++r) {
                const int rel0 = relb - ((r & 3) + 8 * (r >> 2)), rel1 = rel0 - 32;
                const float b0 = tbl[rel0 < 0 ? 0 : (rel0 > 127 ? 127 : rel0)], b1 = tbl[rel1 < 0 ? 0 : (rel1 > 127 ? 127 : rel1)];
                p0[r] = rel0 < 0 ? -INFINITY : p0[r] + b0; p1[r] = rel1 < 0 ? -INFINITY : p1[r] + b1;
            }
        }
        float rm = fmaxf(p0[0], p1[0]);
#pragma unroll
        for (int r = 1; r < 16; ++r) rm = fmaxf(rm, fmaxf(p0[r], p1[r]));
        rm = partner_combine_max(rm);
        const float mn = fmaxf(mrun, rm);
        const float alpha = __builtin_amdgcn_exp2f(mrun - mn);
        mrun = mn; l *= alpha;
#pragma unroll
        for (int nt = 0; nt < 4; ++nt)
#pragma unroll
            for (int r = 0; r < 16; ++r) o[nt][r] *= alpha;
        float s = 0.f;
#pragma unroll
        for (int r = 0; r < 16; ++r) { p0[r] = __builtin_amdgcn_exp2f(p0[r] - mn); p1[r] = __builtin_amdgcn_exp2f(p1[r] - mn); s += p0[r] + p1[r]; }
        l += s;
        pv<4>(o, vp0 + st, p0, p1);
    }
    ATT_WAIT_BAR();
    return partner_combine_sum(l);
}

__device__ __forceinline__ void diff_unit(int b, int h, int qb, const bf16* PROJ, bf16* O, const float* rel_bias, const float* subln, float lam, LAS unsigned char* shm) {
    const int tid = threadIdx.x, lane = tid & 63, r32 = lane & 31, hi = lane >> 5; const int wid = __builtin_amdgcn_readfirstlane(tid >> 6);
    LAS float* tbl = (LAS float*)(shm + LDS_TBL);
    if (tid < 128) { const int n = tid; int bk = n;
        if (n >= 16) { bk = 16 + (n >= 19) + (n >= 21) + (n >= 24) + (n >= 27) + (n >= 31) + (n >= 35) + (n >= 40) + (n >= 46) + (n >= 52) + (n >= 59) + (n >= 67) + (n >= 77) + (n >= 87) + (n >= 99) + (n >= 113); }
        tbl[n] = rel_bias[bk * 4 + h] * LOG2E; }
    const float c31 = rel_bias[31 * 4 + h] * LOG2E;
    const int q0 = qb * 256; const size_t rowbase = (size_t)b * SEQ;
    const bf16* P0 = PROJ + rowbase * PITCH;
    const bf16* Qw1 = P0 + (size_t)(q0 + wid * 32) * PITCH + C_Q1 + h * 64;
    f32x16 o2[4]; u32x2 o1p[4][4][1];
    {
        f32x16 o1[4];
        const float l1 = diff_map(o1, Qw1, P0 + C_K1 + h * 64, P0 + C_DV + h * 128, q0, wid, lane, shm, tbl, c31);
        const float i1 = 1.0f / l1;
#pragma unroll
        for (int nt = 0; nt < 4; ++nt)
#pragma unroll
            for (int c = 0; c < 4; ++c) { o1p[nt][c][0].x = cvt_pk_bf16(o1[nt][4 * c] * i1, o1[nt][4 * c + 1] * i1); o1p[nt][c][0].y = cvt_pk_bf16(o1[nt][4 * c + 2] * i1, o1[nt][4 * c + 3] * i1); }
    }
    const float l2 = diff_map(o2, Qw1 + (C_Q2 - C_Q1), P0 + C_K2 + h * 64, P0 + C_DV + h * 128, q0, wid, lane, shm, tbl, c31);
    const float i2 = lam / l2;
    float ss = 0.f;
#pragma unroll
    for (int nt = 0; nt < 4; ++nt)
#pragma unroll
        for (int c = 0; c < 4; ++c) {
            const float a0 = bf_lo(o1p[nt][c][0].x) - o2[nt][4 * c] * i2, a1 = bf_hi(o1p[nt][c][0].x) - o2[nt][4 * c + 1] * i2, a2 = bf_lo(o1p[nt][c][0].y) - o2[nt][4 * c + 2] * i2, a3 = bf_hi(o1p[nt][c][0].y) - o2[nt][4 * c + 3] * i2;
            o2[nt][4 * c] = a0; o2[nt][4 * c + 1] = a1; o2[nt][4 * c + 2] = a2; o2[nt][4 * c + 3] = a3; ss += (a0 * a0 + a1 * a1) + (a2 * a2 + a3 * a3); }
    ss = partner_combine_sum(ss);
    const float rs = (1.0f - LAMBDA_INIT) / sqrtf(ss * (1.0f / 128.0f) + NORM_EPS);
    bf16* Ow = O + (rowbase + q0 + wid * 32 + r32) * DM + h * 128;
#pragma unroll
    for (int nt = 0; nt < 4; ++nt)
#pragma unroll
        for (int c = 0; c < 4; ++c) { const int n0 = 32 * nt + 8 * c + 4 * hi; const f32x4 g = *(const f32x4*)(subln + n0);
            u32x2 w; w.x = cvt_pk_bf16(o2[nt][4 * c] * rs * g[0], o2[nt][4 * c + 1] * rs * g[1]); w.y = cvt_pk_bf16(o2[nt][4 * c + 2] * rs * g[2], o2[nt][4 * c + 3] * rs * g[3]);
            *(u32x2*)(Ow + n0) = w; }
}

template <bool BAND> __device__ __forceinline__ void sb_sub(f32x16& p, float& R, int krel  , int hi) {
    float f[16];
#pragma unroll
    for (int r = 0; r < 16; ++r) {
        const float z = fmaxf(p[r], -100.0f);
        const float u = __builtin_amdgcn_exp2f(-z);
        float bt = __builtin_amdgcn_rcpf(1.0f + u);
        float ff = u * bt;
        if (BAND) { const bool masked = (krel - ((r & 3) + 8 * (r >> 2))) <= 0; bt = masked ? 0.f : bt; ff = masked ? 1.f : ff; }
        p[r] = bt; f[r] = ff;
    }
    float GP[4], PS[4];
#pragma unroll
    for (int c = 0; c < 4; ++c) { const float g = (f[4 * c] * f[4 * c + 1]) * (f[4 * c + 2] * f[4 * c + 3]);
        auto rr = __builtin_amdgcn_permlane32_swap(__float_as_uint(g), __float_as_uint(g), false, false);
        const float a0 = __uint_as_float(rr[0]), a1 = __uint_as_float(rr[1]);
        GP[c] = a0 * a1; PS[c] = hi ? 1.0f : a1; }
    float T = R;
#pragma unroll
    for (int c = 3; c >= 0; --c) {
        const float base = T * PS[c];
        const float s3 = base, s2 = s3 * f[4 * c + 3], s1 = s2 * f[4 * c + 2], s0 = s1 * f[4 * c + 1];
        p[4 * c + 3] *= s3; p[4 * c + 2] *= s2; p[4 * c + 1] *= s1; p[4 * c] *= s0;
        T *= GP[c];
    }
    R = T;
}

__device__ __forceinline__ void sb_unit(int b, int h, int qb, const bf16* PROJ, bf16* O, LAS unsigned char* shm) {
    const int tid = threadIdx.x, lane = tid & 63, r32 = lane & 31, hi = lane >> 5; const int wid = __builtin_amdgcn_readfirstlane(tid >> 6);
    const unsigned lds0 = (unsigned)(uintptr_t)shm;
    const int q0 = qb * 256; const size_t rowbase = (size_t)b * SEQ;
    const bf16* P0 = PROJ + rowbase * PITCH;
    const bf16* Qw = P0 + (size_t)(q0 + wid * 32) * PITCH + C_SQ + h * 64;
    const bf16* Kh = P0 + C_SK + h * 64; const bf16* Vh = P0 + C_SV + h * 64;
    bf16x8 qf[4];
#pragma unroll
    for (int d0 = 0; d0 < 4; ++d0) qf[d0] = *(const bf16x8*)(Qw + (size_t)r32 * PITCH + d0 * 16 + hi * 8);
#pragma unroll
    for (int d0 = 0; d0 < 4; ++d0) asm volatile("" : "+v"(qf[d0]));
    f32x16 o[2]; o[0] = f32x16{}; o[1] = f32x16{};
    float R = 1.0f;
    const int NT = (q0 + 256) / 64;
    const int qlo = q0 + wid * 32, qrow = qlo + r32;
    const LAS unsigned char* kp0 = shm + hi * 1024 + r32 * 16;
    const LAS unsigned char* vp0 = shm + 8192 + ((lane >> 4) & 1) * 32 + (lane & 3) * 8 + (4 * hi + ((lane & 15) >> 2)) * 64;
    dma_k(Kh + (size_t)(NT - 1) * 64 * PITCH, lds0 + ((NT - 1) & 1) * STAGE, wid, lane); dma_v<2>(Vh + (size_t)(NT - 1) * 64 * PITCH, lds0 + ((NT - 1) & 1) * STAGE + 8192, wid, lane);
    for (int t = NT - 1; t >= 0; --t) {
        ATT_WAIT_BAR();
        const int st = (t & 1) * STAGE;
        if (t > 0) { const int sn = ((t - 1) & 1) * STAGE; dma_k(Kh + (size_t)(t - 1) * 64 * PITCH, lds0 + sn, wid, lane); dma_v<2>(Vh + (size_t)(t - 1) * 64 * PITCH, lds0 + sn + 8192, wid, lane); }
        const int k0 = t * 64;
        if (k0 >= qlo + 31) continue;
        f32x16 p0, p1;
        qkt(p0, p1, kp0 + st, qf);
        int krel = qrow - (k0 + 4 * hi); asm volatile("" : "+v"(krel));
        if (k0 + 63 >= qlo) { sb_sub<true>(p1, R, krel - 32, hi); sb_sub<true>(p0, R, krel, hi); }
        else { sb_sub<false>(p1, R, 0, hi); sb_sub<false>(p0, R, 0, hi); }
        pv<2>(o, vp0 + st, p0, p1);
    }
    ATT_WAIT_BAR();
    bf16* Ow = O + (rowbase + qrow) * DM + 512 + h * 64;
#pragma unroll
    for (int nt = 0; nt < 2; ++nt)
#pragma unroll
        for (int c = 0; c < 4; ++c) { const int n0 = 32 * nt + 8 * c + 4 * hi;
            u32x2 w; w.x = cvt_pk_bf16(o[nt][4 * c], o[nt][4 * c + 1]); w.y = cvt_pk_bf16(o[nt][4 * c + 2], o[nt][4 * c + 3]);
            *(u32x2*)(Ow + n0) = w; }
}
#undef ATT_SBAR
}

#define XB_TMO      128
#define XB_XCNT(j)  (256  + 64 * (j))
#define XB_XSUB(j)  (1280 + 64 * (j))
#define XB_XGEN(j)  (2304 + 64 * (j))
#define XB_TOP      3328
#define XB_TOPGEN   3392
#define XCD_BAR_WORDS 3456
#define XB_SPIN_CAP (1u << 18)
__device__ __forceinline__ unsigned xb_ld(unsigned* p)              { return __hip_atomic_load(p, __ATOMIC_RELAXED, __HIP_MEMORY_SCOPE_AGENT); }
__device__ __forceinline__ unsigned xb_add(unsigned* p, unsigned v) { return __hip_atomic_fetch_add(p, v, __ATOMIC_RELAXED, __HIP_MEMORY_SCOPE_AGENT); }
__device__ __forceinline__ unsigned xb_xcc_id() { return (unsigned)__builtin_amdgcn_s_getreg((3 << 11) | 20) & 0xFu; }
#define XB_SPIN(cond, bar) do { unsigned _sp = 0; while (cond) { __builtin_amdgcn_s_sleep(1); \
    if ((++_sp & 255u) == 0u) { if (xb_ld(&(bar)[XB_TMO])) break; if (_sp > XB_SPIN_CAP) { atomicAdd(&(bar)[XB_TMO], 1u); break; } } } } while (0)
struct XcdBarrier { unsigned* bar; unsigned x; volatile LAS unsigned* st; };
__device__ __forceinline__ XcdBarrier xcd_barrier_post(unsigned* bar, volatile LAS unsigned* st) {
    XcdBarrier b; b.bar = bar; b.x = xb_xcc_id(); b.st = st;
    if (threadIdx.x == 0) (void)xb_add(&bar[XB_XCNT(b.x)], 1u);
    return b;
}
__device__ __forceinline__ void xcd_barrier_complete(unsigned* bar, unsigned x, unsigned& nloc, unsigned& nx) {
    const unsigned G = gridDim.x * gridDim.y * gridDim.z;
    unsigned sum, cnt, mine, sp = 0u;
    for (;;) {
        sum = 0u; cnt = 0u; mine = 0u;
#pragma unroll
        for (unsigned j = 0; j < 16; ++j) { const unsigned c = xb_ld(&bar[XB_XCNT(j)]); sum += c; cnt += (c > 0u) ? 1u : 0u; mine = (j == x) ? c : mine; }
        if (sum == G) break;
        __builtin_amdgcn_s_sleep(1);
        if ((++sp & 255u) == 0u) { if (xb_ld(&bar[XB_TMO])) break; if (sp > XB_SPIN_CAP) { atomicAdd(&bar[XB_TMO], 1u); break; } }
    }
    nloc = mine > 0u ? mine : 1u; nx = cnt > 0u ? cnt : 1u;
}
__device__ __forceinline__ void xcd_barrier(const XcdBarrier& b) {
    asm volatile("s_waitcnt vmcnt(0)" ::: "memory");
    __syncthreads();
    if (threadIdx.x == 0) {
        unsigned* bar = b.bar;
        __builtin_amdgcn_s_waitcnt(0);
        unsigned nloc = b.st[0], nx = b.st[1];
        if (nloc == 0u) { xcd_barrier_complete(bar, b.x, nloc, nx); b.st[0] = nloc; b.st[1] = nx; }
        const unsigned old = xb_add(&bar[XB_XSUB(b.x)], 1u);
        const unsigned gen = old / nloc;
        if (old + 1u == (gen + 1u) * nloc) {
            __builtin_amdgcn_fence(__ATOMIC_RELEASE, "agent");
            asm volatile("s_waitcnt vmcnt(0)" ::: "memory");
            const unsigned og = xb_add(&bar[XB_TOP], 1u);
            const unsigned tg = og / nx;
            if (og + 1u == (tg + 1u) * nx) xb_add(&bar[XB_TOPGEN], 1u);
            else XB_SPIN(xb_ld(&bar[XB_TOPGEN]) == tg, bar);
            __builtin_amdgcn_fence(__ATOMIC_ACQUIRE, "agent");
            xb_add(&bar[XB_XGEN(b.x)], 1u);
            asm volatile("s_waitcnt vmcnt(0)" ::: "memory");
        } else {
            XB_SPIN(xb_ld(&bar[XB_XGEN(b.x)]) == gen, bar);
            __builtin_amdgcn_fence(__ATOMIC_ACQUIRE, "agent");
            asm volatile("s_waitcnt vmcnt(0)" ::: "memory");
        }
    }
    __syncthreads();
}

struct Args {
    const float *x, *p, *w_in, *w_out, *attn_norm, *moe_norm, *rel_bias, *lq1, *lk1, *lq2, *lk2, *subln, *router_w, *router_b, *w_gu, *b_gu, *w_dn, *b_dn, *ple_proj, *ple_norm, *ple_gate, *final_norm;
    float* out; unsigned char* ws; int ph_lo, ph_hi;
};

template <bool GLU> __device__ __forceinline__ void p0_transpose_item(const float* W, int K, int N, bf16* WT, LAS float* scr, int item, int lane) {
    const int nblk = N / 32, kb = item / nblk, nb = item % nblk, k0 = 64 * kb, n0 = 32 * nb;
#pragma unroll 8
    for (int i = 0; i < 32; ++i) { const int kk = 2 * i + (lane >> 5); scr[kk * 33 + (lane & 31)] = W[(size_t)(k0 + kk) * N + n0 + (lane & 31)]; }
    LDS_WAIT(); asm volatile("" ::: "memory");
    const int c = lane & 7;
#pragma unroll
    for (int j = 0; j < 4; ++j) { const int n = (lane >> 3) + 8 * j; const LAS float* s = scr + (8 * c) * 33 + n;
        v4u o; o.x = pk2(s[0 * 33], s[1 * 33]); o.y = pk2(s[2 * 33], s[3 * 33]); o.z = pk2(s[4 * 33], s[5 * 33]); o.w = pk2(s[6 * 33], s[7 * 33]);
        int nn = n0 + n; if (GLU) { const int jj = nn >> 1; nn = 256 * (jj >> 7) + 128 * (nn & 1) + (jj & 127); }
        *(GAS v4u*)(WT + (size_t)nn * K + k0 + 8 * c) = o; }
    LDS_WAIT(); asm volatile("" ::: "memory");
}
template <bool GLU> __device__ __forceinline__ void conv_items(const float* W, int K, int N, bf16* WT, LAS float* scr, int item0, int nitems, int lane) {
    const int nblk = N / 32, lr = lane >> 3, lc = 4 * (lane & 7), c = lane & 7;
    f32x4 v[8], vn[8];
    { const int kb = item0 / nblk, nb = item0 % nblk; const float* src = W + (size_t)(64 * kb + lr) * N + 32 * nb + lc;
#pragma unroll
      for (int i = 0; i < 8; ++i) v[i] = *(const GAS f32x4*)(src + (size_t)(8 * i) * N); }
#pragma unroll 1
    for (int it = 0; it < nitems; ++it) {
        const int item = item0 + it, kb = item / nblk, nb = item % nblk, k0 = 64 * kb, n0 = 32 * nb;
        if (it + 1 < nitems) { const int kb2 = (item + 1) / nblk, nb2 = (item + 1) % nblk; const float* src = W + (size_t)(64 * kb2 + lr) * N + 32 * nb2 + lc;
#pragma unroll
            for (int i = 0; i < 8; ++i) vn[i] = *(const GAS f32x4*)(src + (size_t)(8 * i) * N); }
#pragma unroll
        for (int i = 0; i < 8; ++i) { LAS float* d = scr + (lr + 8 * i) * 33 + lc; d[0] = v[i].x; d[1] = v[i].y; d[2] = v[i].z; d[3] = v[i].w; }
        LDS_WAIT(); asm volatile("" ::: "memory");
#pragma unroll
        for (int j = 0; j < 4; ++j) { const int n = (lane >> 3) + 8 * j; const LAS float* s = scr + (8 * c) * 33 + n;
            v4u o; o.x = pk2(s[0 * 33], s[1 * 33]); o.y = pk2(s[2 * 33], s[3 * 33]); o.z = pk2(s[4 * 33], s[5 * 33]); o.w = pk2(s[6 * 33], s[7 * 33]);
            int nn = n0 + n; if (GLU) { const int jj = nn >> 1; nn = 256 * (jj >> 7) + 128 * (nn & 1) + (jj & 127); }
            *(GAS v4u*)(WT + (size_t)nn * K + k0 + 8 * c) = o; }
        LDS_WAIT(); asm volatile("" ::: "memory");
#pragma unroll
        for (int i = 0; i < 8; ++i) v[i] = vn[i];
    }
}
__device__ __forceinline__ void rms_row_to_bf16(const float* xrow, const float* gain, bf16* orow, int lane) {
    const GAS f32x4* xr = (const GAS f32x4*)xrow + lane; const GAS f32x4* gr = (const GAS f32x4*)gain + lane;
    f32x4 v[4]; float s = 0.f;
#pragma unroll
    for (int j = 0; j < 4; ++j) { v[j] = xr[64 * j]; s += (v[j].x * v[j].x + v[j].y * v[j].y) + (v[j].z * v[j].z + v[j].w * v[j].w); }
    const float rstd = 1.f / sqrtf(wave_sum(s) * (1.f / DM) + NORM_EPS);
    GAS unsigned long long* o8 = (GAS unsigned long long*)orow + lane;
#pragma unroll
    for (int j = 0; j < 4; ++j) { const f32x4 g = gr[64 * j]; o8[64 * j] = (unsigned long long)pk2(v[j].x * rstd * g.x, v[j].y * rstd * g.y) | ((unsigned long long)pk2(v[j].z * rstd * g.z, v[j].w * rstd * g.w) << 32); }
}

__global__ void __launch_bounds__(NWAVES * 64, 2) mk_fwd(Args args) {
    extern __shared__ __attribute__((aligned(16))) unsigned char lds_raw[];
    LAS unsigned char* const lds = (LAS unsigned char*)lds_raw;
    volatile LAS unsigned* const MISC = (volatile LAS unsigned*)(lds + MISC_OFF);
    const int tid = threadIdx.x, lane = tid & 63, wave = __builtin_amdgcn_readfirstlane(tid >> 6);
    const int G = gridDim.x; const int bx = blockIdx.x; const int vcu = (G % 8 == 0) ? (bx % 8) * (G / 8) + bx / 8 : bx;
    unsigned char* const ws = args.ws;
    gu32* const ctl = (gu32*)(ws + WS_CTL);
    bf16* const Win_t = (bf16*)(ws + WS_WIN); bf16* const Wout_t = (bf16*)(ws + WS_WOUT); bf16* const Wpg_t = (bf16*)(ws + WS_WPG); bf16* const Wpp_t = (bf16*)(ws + WS_WPP);
    bf16* const Wgu_t = (bf16*)(ws + WS_WGU); bf16* const Wdn_t = (bf16*)(ws + WS_WDN);
    bf16* const XN = (bf16*)(ws + WS_XN); bf16* const OB = (bf16*)(ws + WS_O); bf16* const PROJ = (bf16*)(ws + WS_PROJ);
    float* const H1 = (float*)(ws + WS_H1); float* const WG = (float*)(ws + WS_WG); float* const PESS = (float*)(ws + WS_PESS); bf16* const PE16 = (bf16*)(ws + WS_PE16); bf16* const P16 = (bf16*)(ws + WS_P16);
    bf16* const ACT = (bf16*)(ws + WS_ACT); bf16* const YB = (bf16*)(ws + WS_Y);
    int* const TINFO = (int*)(ws + WS_TINFO); int* const LIST = (int*)(ws + WS_LIST); float* const LGATE = (float*)(ws + WS_LGATE);

    for (int u = tid; u < (LDS_BYTES - MISC_OFF) / 4; u += NWAVES * 64) ((LAS unsigned*)(lds + MISC_OFF))[u] = 0u;
    __syncthreads();
    XcdBarrier bar; bar.bar = (unsigned*)(ctl + CW_BAR); bar.x = 0; bar.st = nullptr;
    if (MK_N_LAUNCHES == 1) bar = xcd_barrier_post((unsigned*)(ctl + CW_BAR), MISC + 8);
    const int lo = args.ph_lo, hi = args.ph_hi;
#define IN(k) (lo <= (k) && (k) < hi)
#define SEAM(k) do { if (IN(k) && IN((k) + 1)) xcd_barrier(bar); } while (0)
#define REPS(k) for (int rep = 0; rep < ((MK_REP == (k)) ? 2 : 1); ++rep)
#define REPBAR(k) do { if (MK_REP == (k) && rep == 0) xcd_barrier(bar); } while (0)

    if (IN(0)) REPS(0) {
        LAS float* scr = (LAS float*)(lds + wave * 16384);
        const int gw = vcu * NWAVES + wave, NGW = G * NWAVES;
        constexpr int I_IN = (DM / 64) * (NIN / 32), I_SQ = (DM / 64) * (DM / 32), I_PP = (PLE / 64) * (DM / 32);
        constexpr int NITEMS = I_IN + 2 * I_SQ + I_PP;
        for (int it = gw; it < NITEMS; it += NGW) {
            int r = it;
            if (r < I_IN) { conv_items<false>(args.w_in, DM, NIN, Win_t, scr, r, 1, lane); continue; } r -= I_IN;
            if (r < I_SQ) { conv_items<false>(args.w_out, DM, DM, Wout_t, scr, r, 1, lane); continue; } r -= I_SQ;
            if (r < I_SQ) { conv_items<false>(args.ple_gate, DM, DM, Wpg_t, scr, r, 1, lane); continue; } r -= I_SQ;
            conv_items<false>(args.ple_proj, PLE, DM, Wpp_t, scr, r, 1, lane);
        }
        for (int i = (vcu * NWAVES + wave) * 64 + lane; i < DM * NEXP; i += G * NWAVES * 64) WG[i] = args.moe_norm[i >> 5] * args.router_w[i];
        for (int m = gw; m < M; m += NGW) {
            rms_row_to_bf16(args.x + (size_t)m * DM, args.attn_norm, XN + (size_t)m * DM, lane);
            const f32x4 pv4 = *((const GAS f32x4*)(args.p + (size_t)m * PLE) + lane);
            *((GAS unsigned long long*)(P16 + (size_t)m * PLE) + lane) = (unsigned long long)pk2(pv4.x, pv4.y) | ((unsigned long long)pk2(pv4.z, pv4.w) << 32);
        }
        REPBAR(0);
    }
    SEAM(0);

    if (IN(1)) REPS(1) {
        pg8::DenseOrder S; S.init(XN, Win_t, M, NIN, DM, G, bx);
        pg8::EpiProj E{PROJ};
        pg8::gemm_phase<pg8::EpiProj, pg8::DenseOrder, true>(lds, S, E);
        REPBAR(1);
    }
    SEAM(1);

    if (IN(2)) {
        float lam;
        { const float a = wave_sum(args.lq1[lane] * args.lk1[lane]), c = wave_sum(args.lq2[lane] * args.lk2[lane]); lam = expf(a) - expf(c) + LAMBDA_INIT; }
        REPS(2) { for (;;) {
            if (tid == 0) MISC[16] = __hip_atomic_fetch_add(ctl + CW_ATTQ + 64 * rep, 1u, RLX_AGENT);
            __syncthreads();
            const int qi = (int)MISC[16];
            __syncthreads();
            if (qi >= 1536) break;
            const int u = qi >> 1;
            if (qi & 1) {
                LAS float* scr = (LAS float*)(lds + wave * 16384);
                if (u < 512) { const int e = u >> 4, kb = u & 15; conv_items<true>(args.w_gu + (size_t)e * DM * 2048, DM, 2048, Wgu_t + (size_t)e * 2048 * DM, scr, kb * 64 + wave * 8, 8, lane); }
                else { const int c2 = u - 512, e = c2 >> 3; conv_items<false>(args.w_dn + (size_t)e * DM * DM, DM, DM, Wdn_t + (size_t)e * DM * DM, scr, (c2 & 7) * 64 + wave * 8, 8, lane); }
                continue;
            }
            const int qb = 7 - u / 96, g = u % 96;
            if (g < 32) att::diff_unit(g >> 2, g & 3, qb, PROJ, OB, args.rel_bias, args.subln, lam, lds);
            else att::sb_unit((g - 32) >> 3, (g - 32) & 7, qb, PROJ, OB, lds);
        } REPBAR(2); }
    }
    SEAM(2);

    if (IN(3)) REPS(3) {
        { pg8::DenseOrder S; S.init(OB, Wout_t, M, DM, DM, G, bx); pg8::EpiResF32 E{args.x, H1};
          pg8::gemm_phase<pg8::EpiResF32, pg8::DenseOrder, false>(lds, S, E); }
        if (MK_PIPE >= 3) { pg8::DenseOrder S; S.init(P16, Wpp_t, M, DM, PLE, G, bx); pg8::EpiPeRaw E{PE16, PESS};
          pg8::gemm_phase<pg8::EpiPeRaw, pg8::DenseOrder, false>(lds, S, E); }
        REPBAR(3);
    }
    SEAM(3);

    if (IN(4) && MK_PIPE >= 2) {
        LAS float* red = (LAS float*)lds;
        LAS float* ssqp = (LAS float*)(lds + 32768);
        LAS float* rstd_s = (LAS float*)(lds + 32768 + 2048);
        LAS int* lcnt = (LAS int*)(lds + TAB_OFF + 512);
        LAS int* lbase = lcnt + 32;
        LAS int* pend = (LAS int*)(lds + TAB_OFF + 1024);
        for (int tile = bx; tile < M / 64; tile += G) {
            const int tb = tile * 64;
            if (tid < 32) lcnt[tid] = 0;
            {
                const int g = wave >> 2, kq = wave & 3, i = lane & 31, kk = lane >> 5;
                const float* xrow = H1 + (size_t)(tb + 32 * g + i) * DM + 256 * kq + 4 * kk;
                const float* wrow = WG + (size_t)(256 * kq + 4 * kk) * NEXP + i;
                f32x16 acc = f32x16{}; float ssq = 0.f;
#pragma unroll 4
                for (int sidx = 0; sidx < 32; ++sidx) {
                    const f32x4 xa = *(const GAS f32x4*)(xrow + 8 * sidx);
                    const float w0 = wrow[(8 * sidx + 0) * NEXP], w1 = wrow[(8 * sidx + 1) * NEXP], w2 = wrow[(8 * sidx + 2) * NEXP], w3 = wrow[(8 * sidx + 3) * NEXP];
                    ssq += (xa.x * xa.x + xa.y * xa.y) + (xa.z * xa.z + xa.w * xa.w);
                    acc = __builtin_amdgcn_mfma_f32_32x32x2f32(xa.x, w0, acc, 0, 0, 0); acc = __builtin_amdgcn_mfma_f32_32x32x2f32(xa.y, w1, acc, 0, 0, 0);
                    acc = __builtin_amdgcn_mfma_f32_32x32x2f32(xa.z, w2, acc, 0, 0, 0); acc = __builtin_amdgcn_mfma_f32_32x32x2f32(xa.w, w3, acc, 0, 0, 0);
                }
#pragma unroll
                for (int r = 0; r < 16; ++r) red[(wave * 16 + r) * 64 + lane] = acc[r];
                ssqp[wave * 64 + lane] = ssq;
            }
            __syncthreads();
            if (tid < 64) { const int g = tid >> 5, i = tid & 31; float sq = 0.f;
#pragma unroll
                for (int kq = 0; kq < 4; ++kq) sq += ssqp[(4 * g + kq) * 64 + i] + ssqp[(4 * g + kq) * 64 + 32 + i];
                rstd_s[tid] = 1.0f / sqrtf(sq * (1.0f / DM) + NORM_EPS); }
            __syncthreads();
            {
                const int g = wave >> 2, e = lane & 31, hi = lane >> 5; const float rb = args.router_b[e];
#pragma unroll
                for (int rr = 0; rr < 4; ++rr) {
                    const int r = 4 * (wave & 3) + rr, tokl = 32 * g + rr + 8 * (wave & 3) + 4 * hi;
                    float v = ((red[((4 * g + 0) * 16 + r) * 64 + lane] + red[((4 * g + 1) * 16 + r) * 64 + lane]) + (red[((4 * g + 2) * 16 + r) * 64 + lane] + red[((4 * g + 3) * 16 + r) * 64 + lane])) * rstd_s[tokl] + rb;
                    float tv[4]; int ti[4];
#pragma unroll
                    for (int k = 0; k < 4; ++k) {
                        float bv = v; int bi = e;
#pragma unroll
                        for (int o = 1; o < 32; o <<= 1) { const float ov = __shfl_xor(bv, o); const int oi = __shfl_xor(bi, o); if (ov > bv || (ov == bv && oi < bi)) { bv = ov; bi = oi; } }
                        tv[k] = bv; ti[k] = bi; if (e == bi) v = -INFINITY;
                    }
                    const float e1 = __expf(tv[1] - tv[0]), e2 = __expf(tv[2] - tv[0]), e3 = __expf(tv[3] - tv[0]); const float inv = 1.0f / (1.0f + e1 + e2 + e3);
                    if (e < 4) { const int k = e; const int ek = k == 0 ? ti[0] : k == 1 ? ti[1] : k == 2 ? ti[2] : ti[3]; const float gk = (k == 0 ? 1.0f : k == 1 ? e1 : k == 2 ? e2 : e3) * inv;
                        const int rank = __hip_atomic_fetch_add(lcnt + ek, 1, __ATOMIC_RELAXED, __HIP_MEMORY_SCOPE_WORKGROUP);
                        const int pi = tokl * 4 + k;
                        pend[pi * 4 + 0] = (tb + tokl) * 4 + k; pend[pi * 4 + 1] = ek; pend[pi * 4 + 2] = rank; pend[pi * 4 + 3] = (int)__float_as_uint(gk); }
                }
            }
            {
                const GAS f32x4* gr = (const GAS f32x4*)args.moe_norm + lane;
                f32x4 gv[4];
#pragma unroll
                for (int j = 0; j < 4; ++j) gv[j] = gr[64 * j];
#pragma unroll 2
                for (int rr = 0; rr < 8; ++rr) { const int m = tb + 8 * wave + rr; const float rs = rstd_s[8 * wave + rr];
                    const GAS f32x4* xr = (const GAS f32x4*)(H1 + (size_t)m * DM) + lane; GAS unsigned long long* o8 = (GAS unsigned long long*)(XN + (size_t)m * DM) + lane;
#pragma unroll
                    for (int j = 0; j < 4; ++j) { const f32x4 xv = xr[64 * j]; o8[64 * j] = (unsigned long long)pk2(xv.x * rs * gv[j].x, xv.y * rs * gv[j].y) | ((unsigned long long)pk2(xv.z * rs * gv[j].z, xv.w * rs * gv[j].w) << 32); } }
            }
            __syncthreads();
            if (tid < 32) { const int c = lcnt[tid]; lbase[tid] = c > 0 ? (int)__hip_atomic_fetch_add(ctl + CW_GCNT + 64 * tid, (unsigned)c, RLX_AGENT) : 0; }
            __syncthreads();
            if (tid < 256) { const int tk = pend[tid * 4 + 0], ek = pend[tid * 4 + 1], rank = pend[tid * 4 + 2]; const float gk = __uint_as_float((unsigned)pend[tid * 4 + 3]);
                const int pos = lbase[ek] + rank;
                LIST[ek * LCAP + pos] = tk >> 2; LGATE[ek * LCAP + pos] = gk; TINFO[tk] = (pos << 5) | ek; }
            __syncthreads();
        }
    }
    SEAM(4);

    LAS int* const tp = (LAS int*)(lds + TAB_OFF); LAS int* const ecnt = tp + 40;
    if ((IN(5) || IN(6) || IN(7)) && MK_PIPE >= 2) {
        if (tid < 32) ecnt[tid] = (int)__hip_atomic_load(ctl + CW_GCNT + 64 * tid, RLX_AGENT);
        __syncthreads();
        if (tid == 0) { int a = 0; for (int e = 0; e < NEXP; ++e) { tp[e] = a; a += (ecnt[e] + 255) >> 8; } tp[NEXP] = a; }
        __syncthreads();
    }

    if (IN(5) && MK_PIPE >= 2) REPS(5) {
        pg8::GroupedOrder<true, 8, 4> S{XN, Wgu_t, (size_t)2048 * DM * 2, LIST, tp, ecnt, DM, G, bx};
        pg8::EpiGlu E{ACT, args.b_gu};
        pg8::gemm_phase<pg8::EpiGlu, pg8::GroupedOrder<true, 8, 4>, true>(lds, S, E);
        REPBAR(5);
    }
    SEAM(5);

    if (IN(6) && MK_PIPE >= 2) REPS(6) {
        pg8::GroupedOrder<false, 4, 8> S{ACT, Wdn_t, (size_t)DM * DM * 2, LIST, tp, ecnt, DM, G, bx};
        pg8::EpiDown E{YB, args.b_dn, LGATE};
        pg8::gemm_phase<pg8::EpiDown, pg8::GroupedOrder<false, 4, 8>, true>(lds, S, E);
        REPBAR(6);
    }
    SEAM(6);

    if (IN(7) && MK_PIPE >= 2) {
        const int gw = vcu * NWAVES + wave, NGW = G * NWAVES;
        typedef int i32x4 __attribute__((ext_vector_type(4)));
        i32x4 tn = (gw < M) ? *(const GAS i32x4*)(TINFO + (size_t)gw * 4) : (i32x4){0, 0, 0, 0};
        for (int m = gw; m < M; m += NGW) {
            const i32x4 tc = tn;
            if (m + NGW < M) tn = *(const GAS i32x4*)(TINFO + (size_t)(m + NGW) * 4);
            GAS f32x4* hr = (GAS f32x4*)(H1 + (size_t)m * DM) + lane;
            f32x4 v[4]; u32x2 yv[4][4];
#pragma unroll
            for (int k = 0; k < 4; ++k) { const int ti = tc[k]; const int e = ti & 31, pos = ti >> 5; const size_t slot = (size_t)tp[e] * 256 + pos;
                const GAS u32x2* yr = (const GAS u32x2*)(YB + slot * DM) + lane;
#pragma unroll
                for (int j = 0; j < 4; ++j) yv[k][j] = yr[64 * j]; }
#pragma unroll
            for (int j = 0; j < 4; ++j) v[j] = hr[64 * j];
#pragma unroll
            for (int k = 0; k < 4; ++k)
#pragma unroll
                for (int j = 0; j < 4; ++j) { const u32x2 w = yv[k][j]; v[j].x += bf_lo(w.x); v[j].y += bf_hi(w.x); v[j].z += bf_lo(w.y); v[j].w += bf_hi(w.y); }
            GAS unsigned long long* o8 = (GAS unsigned long long*)(XN + (size_t)m * DM) + lane;
#pragma unroll
            for (int j = 0; j < 4; ++j) { hr[64 * j] = v[j]; o8[64 * j] = (unsigned long long)pk2(v[j].x, v[j].y) | ((unsigned long long)pk2(v[j].z, v[j].w) << 32); }
        }
    }
    SEAM(7);

    if (IN(8) && MK_PIPE >= 3) REPS(8) {
        pg8::DenseOrder S; S.init(XN, Wpg_t, M, DM, DM, G, bx);
        pg8::EpiPle E{H1, PE16, PESS, args.ple_norm, args.out};
        pg8::gemm_phase<pg8::EpiPle, pg8::DenseOrder, false>(lds, S, E);
        REPBAR(8);
    }
    SEAM(8);

    if (IN(9)) {
        const int gw = vcu * NWAVES + wave, NGW = G * NWAVES;
        const float* src = (MK_PIPE >= 3) ? args.out : H1;
        for (int m = gw; m < M; m += NGW) {
            const GAS f32x4* xr = (const GAS f32x4*)(src + (size_t)m * DM) + lane; const GAS f32x4* gr = (const GAS f32x4*)args.final_norm + lane;
            f32x4 v[4]; float s = 0.f;
#pragma unroll
            for (int j = 0; j < 4; ++j) { v[j] = xr[64 * j]; s += (v[j].x * v[j].x + v[j].y * v[j].y) + (v[j].z * v[j].z + v[j].w * v[j].w); }
            const float rstd = 1.f / sqrtf(wave_sum(s) * (1.f / DM) + NORM_EPS);
            GAS f32x4* orow = (GAS f32x4*)(args.out + (size_t)m * DM) + lane;
#pragma unroll
            for (int j = 0; j < 4; ++j) { const f32x4 g = gr[64 * j]; orow[64 * j] = (f32x4){v[j].x * rstd * g.x, v[j].y * rstd * g.y, v[j].z * rstd * g.z, v[j].w * rstd * g.w}; }
        }
    }
#undef IN
#undef SEAM
}

extern "C" void kernel_launch(void* const* d_in, const int* in_sizes, int n_in, void* d_out, int out_size, void* d_ws, size_t ws_size, hipStream_t stream) {
    static int grid = 0;
    if (grid == 0) {
        if (n_in != 22 || in_sizes[0] != M * DM || out_size != M * DM || ws_size < WS_END) { fprintf(stderr, "kernel_launch: unexpected shapes (n_in %d, in0 %d, out %d, ws %zu); nothing launched\n", n_in, n_in > 0 ? in_sizes[0] : -1, out_size, ws_size); grid = -1; return; }
        int dev = 0, cus = 0, per_cu = 0;
        if (hipGetDevice(&dev) != hipSuccess || hipDeviceGetAttribute(&cus, hipDeviceAttributeMultiprocessorCount, dev) != hipSuccess) { grid = -1; return; }
        if (hipFuncSetAttribute((const void*)mk_fwd, hipFuncAttributeMaxDynamicSharedMemorySize, LDS_BYTES) != hipSuccess) { fprintf(stderr, "kernel_launch: hipFuncSetAttribute failed\n"); grid = -1; return; }
        if (hipOccupancyMaxActiveBlocksPerMultiprocessor(&per_cu, (const void*)mk_fwd, NWAVES * 64, LDS_BYTES) != hipSuccess || per_cu < 1) fprintf(stderr, "kernel_launch: occupancy query reports %d\n", per_cu);
        (void)hipGetLastError();
        grid = cus;
        if (grid != 256) { fprintf(stderr, "kernel_launch: built for a 256-CU device, found %d CUs; nothing launched\n", cus); grid = -1; return; }
    }
    if (grid < 0) return;
    if (hipMemsetAsync((char*)d_ws + WS_CTL, 0, CTL_ZERO_BYTES, stream) != hipSuccess) return;
    Args a{};
    a.x = (const float*)d_in[0]; a.p = (const float*)d_in[1]; a.w_in = (const float*)d_in[2]; a.w_out = (const float*)d_in[3]; a.attn_norm = (const float*)d_in[4]; a.moe_norm = (const float*)d_in[5];
    a.rel_bias = (const float*)d_in[6]; a.lq1 = (const float*)d_in[7]; a.lk1 = (const float*)d_in[8]; a.lq2 = (const float*)d_in[9]; a.lk2 = (const float*)d_in[10]; a.subln = (const float*)d_in[11];
    a.router_w = (const float*)d_in[12]; a.router_b = (const float*)d_in[13]; a.w_gu = (const float*)d_in[14]; a.b_gu = (const float*)d_in[15]; a.w_dn = (const float*)d_in[16]; a.b_dn = (const float*)d_in[17];
    a.ple_proj = (const float*)d_in[18]; a.ple_norm = (const float*)d_in[19]; a.ple_gate = (const float*)d_in[20]; a.final_norm = (const float*)d_in[21];
    a.out = (float*)d_out; a.ws = (unsigned char*)d_ws;
    for (int li = 0; li < MK_N_LAUNCHES; ++li) {
        a.ph_lo = (MK_N_LAUNCHES == 1) ? 0 : li; a.ph_hi = (MK_N_LAUNCHES == 1) ? N_PHASES : li + 1;
        hipLaunchKernelGGL(mk_fwd, dim3(grid), dim3(NWAVES * 64), LDS_BYTES, stream, a);
        const hipError_t le = hipPeekAtLastError();
        if (le != hipSuccess) { fprintf(stderr, "kernel_launch: launch %d failed: %s\n", li, hipGetErrorName(le)); break; }
    }
}
```
